# Optimizing an MI355X kernel written in HIP

```python
import jax
import jax.numpy as jnp
from jax import lax
import numpy as np

D_MODEL = 1024
BATCH = 16
SEQ = 2048
DEPTH = 4

GRID_W = 64
CTX_LEN = 256
HG_HEADS = 4
HG_HEAD_DIM = 128
HG_WIDTH = HG_HEADS * HG_HEAD_DIM
DN_HEADS = 4
DN_HEAD_DIM = 128
DN_WIDTH = DN_HEADS * DN_HEAD_DIM
MIX_WIDTH = HG_WIDTH + DN_WIDTH
HG_CHUNK = 32
DN_CHUNK = 64
CONV_SIZE = 3
N_GROUPS = 4
EXPERTS_PER_GROUP = 4
N_EXPERTS = N_GROUPS * EXPERTS_PER_GROUP
TOP_K_IN_GROUP = 2
EXPERT_FF = 512
NORM_EPS = 1e-6
IN_SPLITS = [HG_WIDTH] * 5 + [DN_WIDTH] * 4 + [DN_HEADS] * 4
IN_COLS = sum(IN_SPLITS)

kernel_name = 'hybrid_hgrn2_gdn_hmoe_dit'


def rms_norm(x, w):
    x32 = x.astype(jnp.float32)
    y = x32 * lax.rsqrt(jnp.mean(x32 * x32, axis=-1, keepdims=True) + NORM_EPS)
    return (y * w.astype(jnp.float32)).astype(x.dtype)


def modulate(h, shift, scale):
    return h * (1 + scale) + shift


def l2_normalize(t):
    t32 = t.astype(jnp.float32)
    return (t32 * lax.rsqrt(jnp.sum(t32 * t32, axis=-1, keepdims=True) + NORM_EPS)).astype(t.dtype)


def to_heads(t, n_heads):
    b, length, width = t.shape
    return t.reshape(b, length, n_heads, width // n_heads).transpose(0, 2, 1, 3)


def gated_head_norm(o, gate, w):
    y = rms_norm(o, w) * jax.nn.silu(gate)
    b, h, length, d = y.shape
    return y.transpose(0, 2, 1, 3).reshape(b, length, h * d)


def split_in_proj(p):
    bounds = [int(v) for v in np.cumsum(IN_SPLITS)[:-1]]
    return jnp.split(p, bounds, axis=-1)


def gla_chunk_scan(q, k, v, log_f, s0):
    b, h, length, dk = q.shape
    dv = v.shape[-1]
    n = length // HG_CHUNK
    incl = jnp.tril(jnp.ones((HG_CHUNK, HG_CHUNK), dtype=bool))[:, :, None]

    def to_chunks(t):
        return jnp.moveaxis(t.reshape(b, h, n, HG_CHUNK, t.shape[-1]), 2, 0)

    def step(state, inp):
        qc, kc, vc, fc = inp
        cum = jnp.cumsum(fc, axis=2)
        diff = cum[:, :, :, None, :] - cum[:, :, None, :, :]
        decay = jnp.where(incl, jnp.exp(jnp.where(incl, diff, 0.0)), 0.0)
        attn = jnp.einsum('bhtd,bhsd,bhtsd->bhts', qc, kc, decay)
        o = jnp.einsum('bhtd,bhde->bhte', qc * jnp.exp(cum), state) + jnp.einsum('bhts,bhse->bhte', attn, vc)
        last = cum[:, :, -1, :]
        k_dec = kc * jnp.exp(last[:, :, None, :] - cum)
        state = jnp.exp(last)[..., None] * state + jnp.einsum('bhsd,bhse->bhde', k_dec, vc)
        return state, o

    state, o = lax.scan(step, s0, (to_chunks(q), to_chunks(k), to_chunks(v), to_chunks(log_f)))
    return jnp.moveaxis(o, 0, 2).reshape(b, h, length, dv), state


def gated_delta_chunk_scan(q, k, v, beta, log_a, s0):
    b, h, length, dk = q.shape
    dv = v.shape[-1]
    n = length // DN_CHUNK
    dt = q.dtype
    qn = q.reshape(b, h, n, DN_CHUNK, dk)
    kn = k.reshape(b, h, n, DN_CHUNK, dk)
    vn = v.reshape(b, h, n, DN_CHUNK, dv)
    bn = beta.reshape(b, h, n, DN_CHUNK).astype(jnp.float32)
    cum = jnp.cumsum(log_a.astype(jnp.float32).reshape(b, h, n, DN_CHUNK), axis=-1)
    incl = jnp.tril(jnp.ones((DN_CHUNK, DN_CHUNK), dtype=bool))
    strict = jnp.tril(jnp.ones((DN_CHUNK, DN_CHUNK), dtype=bool), -1)
    diff = cum[..., :, None] - cum[..., None, :]
    decay = jnp.where(incl, jnp.exp(jnp.where(incl, diff, 0.0)), 0.0)
    kk = jnp.einsum('bhntd,bhnsd->bhnts', kn, kn).astype(jnp.float32)
    a_mat = jnp.where(strict, bn[..., :, None] * kk * decay, 0.0) + jnp.eye(DN_CHUNK, dtype=jnp.float32)
    rhs = jnp.concatenate([kn.astype(jnp.float32) * (bn * jnp.exp(cum))[..., None],
                           vn.astype(jnp.float32) * bn[..., None]], axis=-1)
    sol = lax.linalg.triangular_solve(a_mat, rhs, left_side=True, lower=True, unit_diagonal=True)
    w = sol[..., :dk].astype(dt)
    u = sol[..., dk:].astype(dt)
    qk = jnp.einsum('bhntd,bhnsd->bhnts', qn, kn) * decay.astype(dt)
    q_dec = qn * jnp.exp(cum)[..., None].astype(dt)
    k_dec = kn * jnp.exp(cum[..., -1:] - cum)[..., None].astype(dt)
    g_tot = jnp.exp(cum[..., -1]).astype(dt)

    def step(state, inp):
        w_c, u_c, qk_c, qd_c, kd_c, gt_c = inp
        v_new = u_c - jnp.einsum('bhtd,bhde->bhte', w_c, state)
        o = jnp.einsum('bhtd,bhde->bhte', qd_c, state) + jnp.einsum('bhts,bhse->bhte', qk_c, v_new)
        state = gt_c[..., None, None] * state + jnp.einsum('bhtd,bhte->bhde', kd_c, v_new)
        return state, o

    xs = tuple(jnp.moveaxis(t, 2, 0) for t in (w, u, qk, q_dec, k_dec, g_tot))
    state, o = lax.scan(step, s0, xs)
    return jnp.moveaxis(o, 0, 2).reshape(b, h, length, dv), state


def run_bidirectional(scan_fn, ctx_fwd, lat_fwd, ctx_bwd, lat_bwd, s0):
    oc_f, sc_f = scan_fn(*ctx_fwd, s0)
    ox_f, _ = scan_fn(*lat_fwd, sc_f)
    oc_b, sc_b = scan_fn(*[jnp.flip(t, axis=2) for t in ctx_bwd], s0)
    ox_b, _ = scan_fn(*[jnp.flip(t, axis=2) for t in lat_bwd], sc_b)
    return oc_f + jnp.flip(oc_b, axis=2), ox_f + jnp.flip(ox_b, axis=2)


def hgrn2_log_forget(f_logit, lb):
    return jnp.logaddexp(jnp.log(lb), jnp.log1p(-lb) + jax.nn.log_sigmoid(f_logit))


def hgrn2_branch(cols_c, cols_x, lb, norm_w):
    def prep(cols):
        q, i, g, f_fwd, f_bwd = cols
        q = to_heads(jax.nn.silu(q), HG_HEADS)
        v = to_heads(i, HG_HEADS)
        per_dir = []
        for f_logit, lb_d in ((f_fwd, lb[0]), (f_bwd, lb[1])):
            log_f = to_heads(hgrn2_log_forget(f_logit, lb_d), HG_HEADS)
            per_dir.append((q, -jnp.expm1(log_f), v, log_f))
        return per_dir, to_heads(g, HG_HEADS)

    dirs_c, gc = prep(cols_c)
    dirs_x, gx = prep(cols_x)
    s0 = jnp.zeros((gc.shape[0], HG_HEADS, HG_HEAD_DIM, HG_HEAD_DIM), gc.dtype)
    oc, ox = run_bidirectional(gla_chunk_scan, dirs_c[0], dirs_x[0], dirs_c[1], dirs_x[1], s0)
    return gated_head_norm(oc, gc, norm_w), gated_head_norm(ox, gx, norm_w)


def short_conv_latent(t, w):
    b, length, ch = t.shape
    rows = length // GRID_W
    y = lax.conv_general_dilated(t.reshape(b, rows, GRID_W, ch), w[:, :, None, :], window_strides=(1, 1),
                                 padding='SAME', dimension_numbers=('NHWC', 'HWIO', 'NHWC'),
                                 feature_group_count=ch)
    return y.reshape(b, length, ch)


def short_conv_context(t, w):
    ch = t.shape[-1]
    return lax.conv_general_dilated(t, w[CONV_SIZE // 2][:, None, :], window_strides=(1,), padding='SAME',
                                    dimension_numbers=('NWC', 'WIO', 'NWC'), feature_group_count=ch)


def deltanet_branch(cols_c, cols_x, conv_w, a_log, dt_bias, norm_w):
    def prep(cols, conv_fn):
        q, k, v, z, b_fwd, b_bwd, a_fwd, a_bwd = cols
        qkv = jax.nn.silu(conv_fn(jnp.concatenate([q, k, v], axis=-1), conv_w))
        q, k, v = jnp.split(qkv, 3, axis=-1)
        q = l2_normalize(to_heads(q, DN_HEADS)) * (DN_HEAD_DIM ** -0.5)
        k = l2_normalize(to_heads(k, DN_HEADS))
        v = to_heads(v, DN_HEADS)
        per_dir = []
        for d, (b_logit, a_logit) in enumerate(((b_fwd, a_fwd), (b_bwd, a_bwd))):
            beta = jax.nn.sigmoid(b_logit).transpose(0, 2, 1)
            log_a = (-jnp.exp(a_log[d]) * jax.nn.softplus(a_logit + dt_bias[d])).transpose(0, 2, 1)
            per_dir.append((q, k, v, beta, log_a))
        return per_dir, to_heads(z, DN_HEADS)

    dirs_c, zc = prep(cols_c, short_conv_context)
    dirs_x, zx = prep(cols_x, short_conv_latent)
    s0 = jnp.zeros((zc.shape[0], DN_HEADS, DN_HEAD_DIM, DN_HEAD_DIM), zc.dtype)
    oc, ox = run_bidirectional(gated_delta_chunk_scan, dirs_c[0], dirs_x[0], dirs_c[1], dirs_x[1], s0)
    return gated_head_norm(oc, zc, norm_w), gated_head_norm(ox, zx, norm_w)


def hybrid_mixer(pc, px, lb, hg_norm_w, conv_w, a_log, dt_bias, dn_norm_w):
    cols_c = split_in_proj(pc)
    cols_x = split_in_proj(px)
    hg_c, hg_x = hgrn2_branch(cols_c[:5], cols_x[:5], lb, hg_norm_w)
    dn_c, dn_x = deltanet_branch(cols_c[5:], cols_x[5:], conv_w, a_log, dt_bias, dn_norm_w)
    return jnp.concatenate([hg_c, dn_c], axis=-1), jnp.concatenate([hg_x, dn_x], axis=-1)


def hierarchical_moe(h, w_group, b_group, w_expert, b_expert, w_gate, w_up, w_down):
    t = h.reshape(-1, h.shape[-1])
    g_logits = (t @ w_group + b_group).astype(jnp.float32)
    g_prob = jax.nn.softmax(g_logits, axis=-1)
    g_idx = jnp.argmax(g_logits, axis=-1)
    g_w = jnp.take_along_axis(g_prob, g_idx[:, None], axis=-1)
    e_logits = (t @ w_expert + b_expert).astype(jnp.float32).reshape(-1, N_GROUPS, EXPERTS_PER_GROUP)
    e_in_group = jnp.take_along_axis(e_logits, g_idx[:, None, None], axis=1)[:, 0]
    top_v, top_i = lax.top_k(e_in_group, TOP_K_IN_GROUP)
    top_w = jax.nn.softmax(top_v, axis=-1) * g_w
    expert_id = g_idx[:, None] * EXPERTS_PER_GROUP + top_i
    gates = jnp.sum(jax.nn.one_hot(expert_id, N_EXPERTS, dtype=jnp.float32) * top_w[..., None],
                    axis=1).astype(t.dtype)
    y = jnp.zeros_like(t)
    for e in range(N_EXPERTS):
        a = jax.nn.silu(t @ w_gate[e]) * (t @ w_up[e])
        y = y + gates[:, e:e + 1] * (a @ w_down[e])
    return y.reshape(h.shape)


def setup_inputs(seed: int = 0) -> dict:
    key = jax.random.key(seed)
    ks = jax.random.split(key, 24)
    f32 = jnp.float32

    def nrm(k, shape, scale):
        return jax.random.normal(k, shape, f32) * scale

    a_init = jax.random.uniform(ks[13], (DEPTH, 2, DN_HEADS), f32, minval=1.0, maxval=16.0)
    dt = jnp.exp(jax.random.uniform(ks[14], (DEPTH, 2, DN_HEADS), f32,
                                    minval=float(np.log(1e-3)), maxval=float(np.log(1e-1))))
    return {
        'x': nrm(ks[0], (BATCH, SEQ, D_MODEL), 1.0),
        'c': nrm(ks[1], (BATCH, D_MODEL), 1.0),
        'ctx': nrm(ks[2], (BATCH, CTX_LEN, D_MODEL), 1.0),
        'c_ctx': nrm(ks[3], (D_MODEL,), 1.0),
        'w_mod': nrm(ks[4], (DEPTH, D_MODEL, 6 * D_MODEL), 0.5 * D_MODEL ** -0.5),
        'b_mod': nrm(ks[5], (DEPTH, 6 * D_MODEL), 0.02),
        'norm1_w': 1.0 + nrm(ks[6], (DEPTH, D_MODEL), 0.02),
        'norm2_w': 1.0 + nrm(ks[7], (DEPTH, D_MODEL), 0.02),
        'w_in': nrm(ks[8], (DEPTH, D_MODEL, IN_COLS), D_MODEL ** -0.5),
        'w_out': nrm(ks[9], (DEPTH, MIX_WIDTH, D_MODEL), MIX_WIDTH ** -0.5),
        'hg_lb': nrm(ks[10], (DEPTH, 2, HG_WIDTH), 0.1),
        'hg_norm_w': 1.0 + nrm(ks[11], (DEPTH, HG_HEAD_DIM), 0.02),
        'dn_conv_w': nrm(ks[12], (DEPTH, CONV_SIZE, CONV_SIZE, 3 * DN_WIDTH), 1.0 / CONV_SIZE),
        'dn_a_log': jnp.log(a_init),
        'dn_dt_bias': dt + jnp.log(-jnp.expm1(-dt)),
        'dn_norm_w': 1.0 + nrm(ks[15], (DEPTH, DN_HEAD_DIM), 0.02),
        'w_group': nrm(ks[16], (DEPTH, D_MODEL, N_GROUPS), D_MODEL ** -0.5),
        'b_group': nrm(ks[17], (DEPTH, N_GROUPS), 0.01),
        'w_expert': nrm(ks[18], (DEPTH, D_MODEL, N_EXPERTS), D_MODEL ** -0.5),
        'b_expert': nrm(ks[19], (DEPTH, N_EXPERTS), 0.01),
        'w_gate': nrm(ks[20], (DEPTH, N_EXPERTS, D_MODEL, EXPERT_FF), D_MODEL ** -0.5),
        'w_up': nrm(ks[21], (DEPTH, N_EXPERTS, D_MODEL, EXPERT_FF), D_MODEL ** -0.5),
        'w_down': nrm(ks[22], (DEPTH, N_EXPERTS, EXPERT_FF, D_MODEL), EXPERT_FF ** -0.5),
        'final_norm_w': 1.0 + nrm(ks[23], (D_MODEL,), 0.02),
    }


def reference(x, c, ctx, c_ctx, w_mod, b_mod, norm1_w, norm2_w, w_in, w_out, hg_lb, hg_norm_w,
              dn_conv_w, dn_a_log, dn_dt_bias, dn_norm_w, w_group, b_group, w_expert, b_expert,
              w_gate, w_up, w_down, final_norm_w):
    lb_all = jnp.cumsum(jax.nn.softmax(hg_lb.astype(jnp.float32), axis=0), axis=0)
    lb_all = (lb_all - lb_all[0]).astype(x.dtype)
    silu_c = jax.nn.silu(c)
    silu_c_ctx = jax.nn.silu(c_ctx)
    xs, cs = x, ctx
    for l in range(DEPTH):
        last = l == DEPTH - 1
        sh1x, sc1x, g1x, sh2x, sc2x, g2x = jnp.split((silu_c @ w_mod[l] + b_mod[l])[:, None, :], 6, axis=-1)
        sh1c, sc1c, g1c, sh2c, sc2c, g2c = jnp.split((silu_c_ctx @ w_mod[l] + b_mod[l])[None, None, :], 6, axis=-1)
        hx = modulate(rms_norm(xs, norm1_w[l]), sh1x, sc1x)
        hc = modulate(rms_norm(cs, norm1_w[l]), sh1c, sc1c)
        oc, ox = hybrid_mixer(hc @ w_in[l], hx @ w_in[l], lb_all[l], hg_norm_w[l], dn_conv_w[l],
                              dn_a_log[l], dn_dt_bias[l], dn_norm_w[l])
        moe_args = (w_group[l], b_group[l], w_expert[l], b_expert[l], w_gate[l], w_up[l], w_down[l])
        xs = xs + g1x * (ox @ w_out[l])
        xs = xs + g2x * hierarchical_moe(modulate(rms_norm(xs, norm2_w[l]), sh2x, sc2x), *moe_args)
        if not last:
            cs = cs + g1c * (oc @ w_out[l])
            cs = cs + g2c * hierarchical_moe(modulate(rms_norm(cs, norm2_w[l]), sh2c, sc2c), *moe_args)
    return rms_norm(xs, final_norm_w)
```

```cpp
#include <hip/hip_runtime.h>
#include <cstdio>
#include <cstdint>

#ifndef MK_PROBE
#define MK_PROBE (-1)
#define MK_PROBE_DRY 0
#define MK_PROBE_REP 1
#endif
#ifndef MK_PER_PHASE_LAUNCH
#define MK_PER_PHASE_LAUNCH 0
#endif

#define DI __device__ __forceinline__
#define LAS __attribute__((address_space(3)))
#define GAS __attribute__((address_space(1)))
typedef unsigned short bf16;
typedef short bf16x8 __attribute__((ext_vector_type(8)));
typedef float f32x4 __attribute__((ext_vector_type(4)));
typedef float f32x2 __attribute__((ext_vector_type(2)));
typedef unsigned u32x4 __attribute__((ext_vector_type(4)));
typedef unsigned u32x2 __attribute__((ext_vector_type(2)));
typedef GAS unsigned gu32;

constexpr int D = 1024, NB = 16, SEQ = 2048, CTXL = 256, RPB = SEQ + CTXL, T = NB * RPB, DEPTH = 4;
constexpr int INC = 4624, NP = 4608;
constexpr int HD = 128;
constexpr int NE = 16, FF = 512;
constexpr float EPS = 1e-6f;
constexpr int MODW = 6 * D;

constexpr size_t MiB = 1u << 20;
constexpr size_t WS_CTL = 0, CTL_ZERO_BYTES = 1 * MiB;
constexpr size_t WS_MOD = 1 * MiB;
constexpr size_t WS_LB = 3 * MiB;
constexpr size_t WS_CA = 3 * MiB + 64 * 1024;
constexpr size_t WS_CH = 3 * MiB + 96 * 1024;
constexpr size_t WS_BETA = 4 * MiB;
constexpr size_t WS_LOGA = 5 * MiB + 256 * 1024;
constexpr size_t WS_CUM = 6 * MiB + 512 * 1024;
constexpr size_t WS_LIST = 8 * MiB;
constexpr size_t WS_LISTW = 11 * MiB;
constexpr size_t WS_WIN = 14 * MiB;
constexpr size_t WS_WOUT = 23 * MiB;
constexpr size_t WS_XS = 26 * MiB;
constexpr size_t WS_HBQ = 170 * MiB;
constexpr size_t WS_PHG = 278 * MiB;
constexpr size_t WS_PZ = 458 * MiB;
constexpr size_t WS_PREP = 494 * MiB;
constexpr size_t WS_QKD = 674 * MiB;
constexpr size_t WS_END = 710 * MiB;
constexpr size_t PREP_RAW = 0, PREP_U = 108 * MiB;
constexpr size_t XSLOT_W = 72 * MiB;
constexpr size_t HBQ_QKN = 0, HBQ_QKD = 72 * MiB;
constexpr size_t PREP_WGU = 0, PREP_WDN = 32 * MiB, PREP_ACT = 48 * MiB;
constexpr int MAXTILES = 304;

constexpr int CW_TMO = 0, CW_CODE = 1;
constexpr int CW_BAR = 4096;
constexpr int CW_CNT = 16384;

constexpr int RING_BYTES = 131072;
constexpr int LDSCTL_OFF = RING_BYTES, MISC_OFF = LDSCTL_OFF + 320;
constexpr int TAB_OFF = LDSCTL_OFF + 1024;
constexpr int LDS_BYTES = 147456;

#define RLX_AGENT __ATOMIC_RELAXED, __HIP_MEMORY_SCOPE_AGENT
#define LDS_WAIT() asm volatile("s_waitcnt lgkmcnt(0)" ::: "memory")
#define VM_WAIT() asm volatile("s_waitcnt vmcnt(0)" ::: "memory")

DI float bf2f(unsigned short b) { return __uint_as_float(((unsigned)b) << 16); }
DI unsigned cvt_pk_bf16(float lo, float hi) { unsigned r; asm volatile("v_cvt_pk_bf16_f32 %0, %1, %2" : "=v"(r) : "v"(lo), "v"(hi)); return r; }
DI float bflo(unsigned w) { return __uint_as_float(w << 16); }
DI float bfhi(unsigned w) { return __uint_as_float(w & 0xffff0000u); }
DI float silu_f(float x) { return x * __builtin_amdgcn_rcpf(1.0f + __expf(-x)); }
DI float sigmoid_f(float x) { return __builtin_amdgcn_rcpf(1.0f + __expf(-x)); }
DI float softplus_f(float x) { const float e = __expf(-fabsf(x)); return fmaxf(x, 0.f) + (e < 0.01f ? e * (1.0f - e * (0.5f - 0.33333333f * e)) : __logf(1.0f + e)); }
template <int M> DI float swz(float v) { static_assert(M >= 1 && M <= 16, "xor mask"); return __int_as_float(__builtin_amdgcn_ds_swizzle(__float_as_int(v), (M << 10) | 0x1f)); }
DI float pair32(float a, float b) { auto r = __builtin_amdgcn_permlane32_swap(__float_as_uint(a), __float_as_uint(b), false, false); return __uint_as_float(r[0]) + __uint_as_float(r[1]); }
DI float add_x32(float v) { return pair32(v, v); }
DI float lane_get(float v, int src) { return __int_as_float(__builtin_amdgcn_ds_bpermute(src << 2, __float_as_int(v))); }
DI float wave_sum(float v) {
    v += swz<1>(v); v += swz<2>(v); v += swz<4>(v); v += swz<8>(v); v += swz<16>(v);
    return add_x32(v);
}

typedef short s16x4 __attribute__((ext_vector_type(4)));
typedef __bf16 bf16x2_t __attribute__((ext_vector_type(2)));
DI unsigned cvtpk(float lo, float hi) { f32x2 v = {lo, hi}; bf16x2_t b = __builtin_convertvector(v, bf16x2_t); return __builtin_bit_cast(unsigned, b); }
constexpr size_t PHG_G = (size_t)NB * 4 * 2304 * 512;
DI size_t phg_idx(int b, int h, int r) { return ((size_t)(b * 4 + h) * 2304 + r) * 512; }
DI size_t wu_idx(int dir, int b, int h, int srow) { return ((size_t)((dir * NB + b) * 4 + h) * 2304 + srow) * 128; }
DI size_t qkn_idx(int b, int h, int r) { return ((size_t)(b * 4 + h) * 2304 + r) * 384; }
DI s16x4 ds_tr(const LAS unsigned char* p) { return __builtin_bit_cast(s16x4, __builtin_amdgcn_ds_read_tr16_b64_v4i16((LAS s16x4*)p)); }
DI bf16x8 cat8(s16x4 a, s16x4 b) { return __builtin_shufflevector(a, b, 0, 1, 2, 3, 4, 5, 6, 7); }
DI bf16x8 pack8(float a0, float a1, float a2, float a3, float a4, float a5, float a6, float a7) { u32x4 w; w.x = cvtpk(a0, a1); w.y = cvtpk(a2, a3); w.z = cvtpk(a4, a5); w.w = cvtpk(a6, a7); return __builtin_bit_cast(bf16x8, w); }
#define MFMA16(a, b, c) __builtin_amdgcn_mfma_f32_16x16x32_bf16((a), (b), (c), 0, 0, 0)

namespace pg8 {
constexpr int BM = 256, BK = 64, HALF = 128, HTB = HALF * BK * 2, STAGE_BYTES = 8 * HTB, NXCD = 8, WGM = 8;
__host__ __device__ __forceinline__ int lds_byte(int r, int c) { const int st = (r >> 4) * 2 + (c >> 5), rr = r & 15, cc = c & 31, ob = rr * 64 + cc * 2; return st * 1024 + (ob ^ (((ob >> 9) & 1) << 5)); }
__host__ __device__ __forceinline__ void stage_rc(int b, int& R, int& C) { const int st = b / 1024, sb = b % 1024, swz = sb ^ (((sb >> 9) & 1) << 5); R = (st >> 1) * 16 + swz / 64; C = (st & 1) * 32 + (swz % 64) / 2; }
__host__ __device__ __forceinline__ int perm32(int rho) { const int n = rho >> 4, i = rho & 15; return 8 * (i >> 2) + 4 * n + (i & 3); }

struct Unit { int pm, pn, e, r0, ne; };

struct StaticOrder {
    int nM, nN, nwg, G, c;
    __device__ void init(int M, int N, int G_, int c_) { nM = M / BM; nN = N / BM; nwg = nM * nN; G = G_; c = c_; }
    __device__ bool next(int i, Unit& u) const {
        const long L = (long)i * G + c; if (L >= nwg) return false;
        int wgid = (int)L; { const int q = nwg / NXCD, r = nwg % NXCD, xcd = wgid % NXCD, off = wgid / NXCD; wgid = (xcd < r ? xcd * (q + 1) : r * (q + 1) + (xcd - r) * q) + off; }
        const int nig = WGM * nN, gid = wgid / nig, fm = gid * WGM, gsz = (nM - fm) < WGM ? (nM - fm) : WGM;
        u.pm = fm + ((wgid % nig) % gsz); u.pn = (wgid % nig) / gsz; u.e = 0; u.r0 = 0; u.ne = 0; return true;
    }
};
struct DenseSched {
    StaticOrder so; const char* Bt; int K; int skipctx;
    DI bool next(int i, Unit& u) const { if (!so.next(i, u)) return false; if (skipctx) u.pm = u.pm + u.pm / 8 + 1; return true; }
    DI const char* bptr(const Unit& u) const { return Bt + (size_t)u.pn * BM * K * 2; }
    DI unsigned arow(const Unit& u, int row) const { return (unsigned)(u.pm * BM + row) * (unsigned)(K * 2); }
};
template <bool GATHER> struct GroupSched {
    const LAS int* TE; const LAS int* TR0; const LAS int* NEc; int NT, G, c; const char* Bt; size_t bstride; int K; const int* LIST;
    DI bool next(int i, Unit& u) const {
        const int L = i * G + c; if (L >= NT * 4) return false;
        const int ti = L >> 2; u.pm = ti; u.pn = L & 3;
        u.e = __builtin_amdgcn_readfirstlane(TE[ti]); u.r0 = __builtin_amdgcn_readfirstlane(TR0[ti]); u.ne = __builtin_amdgcn_readfirstlane(NEc[u.e]); return true;
    }
    DI const char* bptr(const Unit& u) const { return Bt + (size_t)u.e * bstride + (size_t)u.pn * BM * K * 2; }
    DI unsigned arow(const Unit& u, int row) const {
        if (GATHER) { const int pos = u.r0 + row; int tok = 0; if (pos < u.ne) tok = LIST[u.e * T + pos] >> 1; return (unsigned)tok * (unsigned)(K * 2); }
        else return (unsigned)(u.pm * BM + row) * (unsigned)(K * 2);
    }
};

template <class Epi, class Sched, bool ALIGN_EPI>
DI void gemm_phase(LAS unsigned char* lds, const int tid_in, const char* Abase, const int K, const Sched& S, const Epi& E) {
    int tid_ = tid_in; asm volatile("" : "+v"(tid_));
    const int tid = tid_, wid = __builtin_amdgcn_readfirstlane(tid >> 6), lane = tid & 63, wr = wid >> 2, wc = wid & 3, fr = lane & 15, fq = lane >> 4;
    const int nt = K / BK;
    int Rr[2]; unsigned Cb[2], voffB[2];
#pragma unroll
    for (int i = 0; i < 2; ++i) { int R, C; stage_rc(tid * 16 + i * 8192, R, C); const int Rb = Epi::PERM ? ((R & ~31) + perm32(R & 31)) : R;
        Rr[i] = R; Cb[i] = (unsigned)C * 2u; voffB[i] = (unsigned)(Rb * K + C) * 2u; }
    const size_t kstep = (size_t)(BK * 2);
    const size_t hstepB = (size_t)HALF * K * 2;
    const unsigned ldsw = (unsigned)wid * 1024u;
    const int aoff = lds_byte(wr * 64 + fr, fq * 8), boff = lds_byte(wc * 32 + fr, fq * 8);
#define PG8_SA(b, h) (((b) * 2 + (h)) * HTB)
#define PG8_SB(b, h) ((4 + (b) * 2 + (h)) * HTB)
#define PG8_STAGE_B(bufoff, gbase) do { _Pragma("unroll") for (int _i = 0; _i < 2; ++_i) \
        __builtin_amdgcn_global_load_lds((const unsigned*)((const char*)(gbase) + voffB[_i]), (LAS unsigned*)(lds + (bufoff) + ldsw + _i * 8192), 16, 0, 0); } while (0)
#define PG8_STAGE_A(bufoff, offs, kb) do { _Pragma("unroll") for (int _i = 0; _i < 2; ++_i) \
        __builtin_amdgcn_global_load_lds((const unsigned*)((const char*)(Abase + (kb)) + (offs)[_i]), (LAS unsigned*)(lds + (bufoff) + ldsw + _i * 8192), 16, 0, 0); } while (0)
#define PG8_LDA(dst, b, h) do { _Pragma("unroll") for (int m = 0; m < 4; ++m) _Pragma("unroll") for (int k = 0; k < 2; ++k) dst[m][k] = *(const LAS bf16x8*)(lds + PG8_SA(b, h) + aoff + m * 2048 + k * 1024); } while (0)
#define PG8_LDB(dst, b, h) do { _Pragma("unroll") for (int n = 0; n < 2; ++n) _Pragma("unroll") for (int k = 0; k < 2; ++k) dst[n][k] = *(const LAS bf16x8*)(lds + PG8_SB(b, h) + boff + n * 2048 + k * 1024); } while (0)
#define PG8_MMA(ai, bj, At, Bt) do { __builtin_amdgcn_s_setprio(1); _Pragma("unroll") for (int m = 0; m < 4; ++m) _Pragma("unroll") for (int n = 0; n < 2; ++n) _Pragma("unroll") for (int k = 0; k < 2; ++k) \
        acc[ai][bj][m][n] = __builtin_amdgcn_mfma_f32_16x16x32_bf16(Bt[n][k], At[m][k], acc[ai][bj][m][n], 0, 0, 0); __builtin_amdgcn_s_setprio(0); } while (0)
#define PG8_WAIT_V(n) asm volatile("s_waitcnt vmcnt(" #n ")" ::: "memory")
#define PG8_WAIT_L(n) asm volatile("s_waitcnt lgkmcnt(" #n ")" ::: "memory")
#define PG8_BAR __builtin_amdgcn_s_barrier()
#define PG8_SCHED __builtin_amdgcn_sched_barrier(0)
    Unit cur, nxt; int ui = 0;
    if (!S.next(0, cur)) return;
    f32x4 acc[2][2][4][2];
#pragma unroll
    for (int a = 0; a < 2; ++a)
#pragma unroll
        for (int b = 0; b < 2; ++b)
#pragma unroll
            for (int m = 0; m < 4; ++m)
#pragma unroll
                for (int n = 0; n < 2; ++n) acc[a][b][m][n] = (f32x4){0.f, 0.f, 0.f, 0.f};
    bf16x8 At[4][2], B0[2][2], B1[2][2];
    unsigned cA0[2], cA1[2], nA0[2], nA1[2];
#pragma unroll
    for (int i = 0; i < 2; ++i) { cA0[i] = S.arow(cur, Rr[i]) + Cb[i]; cA1[i] = S.arow(cur, HALF + Rr[i]) + Cb[i]; }
    const char* cB = S.bptr(cur);
    PG8_STAGE_B(PG8_SB(0, 0), cB); PG8_STAGE_B(PG8_SB(0, 1), cB + hstepB); PG8_STAGE_A(PG8_SA(0, 0), cA0, 0); PG8_STAGE_A(PG8_SA(0, 1), cA1, 0);
    if (wr == 1) PG8_BAR;
    PG8_WAIT_V(2); PG8_BAR;
    PG8_STAGE_B(PG8_SB(1, 0), cB + kstep); PG8_STAGE_A(PG8_SA(1, 0), cA0, kstep); PG8_STAGE_B(PG8_SB(1, 1), cB + hstepB + kstep);
    PG8_WAIT_V(6); PG8_BAR;
    for (;;) {
        const bool has_next = S.next(ui + 1, nxt);
        u32x2 pre_ = {0u, 0u}; if constexpr (Epi::HAS_PRE) pre_ = E.pre_load(cur, tid);
        const char* nB = cB;
#pragma unroll
        for (int i = 0; i < 2; ++i) { nA0[i] = cA0[i]; nA1[i] = cA1[i]; }
        if (has_next) { nB = S.bptr(nxt);
#pragma unroll
            for (int i = 0; i < 2; ++i) { nA0[i] = S.arow(nxt, Rr[i]) + Cb[i]; nA1[i] = S.arow(nxt, HALF + Rr[i]) + Cb[i]; } }
        for (int t = 0; t < nt; t += 2) {
            const bool last = (t == nt - 2);
            const size_t kb1 = (size_t)(t + 1) * kstep;
            const size_t kb2 = last ? (size_t)0 : (size_t)(t + 2) * kstep, kb3 = kb2 + kstep;
            const char* b2 = last ? nB : cB + kb2; const char* b3 = b2 + kstep;
            unsigned a2h0[2], a2h1[2];
#pragma unroll
            for (int i = 0; i < 2; ++i) { a2h0[i] = last ? nA0[i] : cA0[i]; a2h1[i] = last ? nA1[i] : cA1[i]; }
            PG8_LDB(B0, 0, 0); PG8_LDB(B1, 0, 1); PG8_SCHED; PG8_LDA(At, 0, 0); PG8_STAGE_A(PG8_SA(1, 1), cA1, kb1);
            PG8_WAIT_V(8); PG8_WAIT_L(0); PG8_BAR; PG8_MMA(0, 0, At, B0); PG8_MMA(0, 1, At, B1); PG8_BAR; PG8_SCHED;
            PG8_LDA(At, 0, 1); PG8_STAGE_B(PG8_SB(0, 0), b2); PG8_STAGE_B(PG8_SB(0, 1), b2 + hstepB); PG8_STAGE_A(PG8_SA(0, 0), a2h0, kb2);
            PG8_WAIT_V(8); PG8_WAIT_L(0); PG8_BAR; PG8_MMA(1, 0, At, B0); PG8_MMA(1, 1, At, B1); PG8_BAR; PG8_SCHED;
            PG8_LDB(B0, 1, 0); PG8_LDB(B1, 1, 1); PG8_SCHED; PG8_LDA(At, 1, 0); PG8_STAGE_A(PG8_SA(0, 1), a2h1, kb2);
            PG8_WAIT_V(8); PG8_WAIT_L(0); PG8_BAR; PG8_MMA(0, 0, At, B0); PG8_MMA(0, 1, At, B1); PG8_BAR; PG8_SCHED;
            PG8_LDA(At, 1, 1); PG8_STAGE_B(PG8_SB(1, 0), b3); PG8_STAGE_B(PG8_SB(1, 1), b3 + hstepB); PG8_STAGE_A(PG8_SA(1, 0), a2h0, kb3);
            PG8_WAIT_V(8); PG8_WAIT_L(0); PG8_BAR; PG8_MMA(1, 0, At, B0); PG8_MMA(1, 1, At, B1); PG8_BAR; PG8_SCHED;
        }
        if constexpr (ALIGN_EPI) { if (wr == 0) PG8_BAR; }
        if constexpr (Epi::HAS_PRE) { static_assert(ALIGN_EPI, "the extra barrier needs the aligned wave groups"); E.pre_store(tid, pre_); PG8_WAIT_L(0); PG8_BAR; }
        E(acc, cur, wr, wc, fr, fq);
        if (!has_next) break;
#pragma unroll
        for (int a = 0; a < 2; ++a)
#pragma unroll
            for (int b = 0; b < 2; ++b)
#pragma unroll
                for (int m = 0; m < 4; ++m)
#pragma unroll
                    for (int n = 0; n < 2; ++n) acc[a][b][m][n] = (f32x4){0.f, 0.f, 0.f, 0.f};
        cur = nxt; cB = nB; ++ui;
#pragma unroll
        for (int i = 0; i < 2; ++i) { cA0[i] = nA0[i]; cA1[i] = nA1[i]; }
        if constexpr (ALIGN_EPI) { if (wr == 1) PG8_BAR; }
    }
    PG8_WAIT_V(0);
    if constexpr (!ALIGN_EPI) { if (wr == 0) PG8_BAR; }
    PG8_BAR;
#undef PG8_SA
#undef PG8_SB
#undef PG8_STAGE_A
#undef PG8_STAGE_B
#undef PG8_LDA
#undef PG8_LDB
#undef PG8_MMA
#undef PG8_WAIT_V
#undef PG8_WAIT_L
#undef PG8_BAR
#undef PG8_SCHED
}

DI float logf_gate(float x, float lb) {
    const float sg = __builtin_amdgcn_rcpf(1.0f + __expf(-fmaxf(x, -80.0f)));
    return __builtin_amdgcn_logf(lb + (1.0f - lb) * sg) * 0.69314718056f;
}
struct EpiInProj {
    static constexpr bool PERM = true; static constexpr bool HAS_PRE = false;
    bf16* PHG; bf16* RAW; bf16* PZ; const float* LB;
    DI void operator()(const f32x4 (&acc)[2][2][4][2], const Unit& u, int wr, int wc, int fr, int fq) const {
        const int colu = u.pn * BM; int row0 = u.pm * BM + wr * 64 + fr;
        bf16* base; int ld, cbase, mode; size_t bjstep = HALF;
        if (colu < 2560) { const int blk = colu >> 9; mode = blk == 0 ? 1 : (blk >= 3 ? 2 : 0);
            if (blk == 2) { base = PHG + PHG_G; ld = 512; cbase = colu - 1024; }
            else { const int b = (u.pm * BM) / 2304, slot = blk == 0 ? 0 : (blk == 1 ? 1 : blk - 1);
                base = PHG + phg_idx(b, (colu & 511) >> 7, 0) + slot * 128; ld = 512; cbase = 0; row0 -= b * 2304; bjstep = (size_t)2304 * 512; } }
        else if (colu < 4096) { base = RAW; ld = 1536; cbase = colu - 2560; mode = 0; }
        else { base = PZ; ld = 512; cbase = colu - 4096; mode = 0; }
        const int lcol = wc * 32 + 8 * fq;
        if (mode == 2) {
            float lbv[2][8];
#pragma unroll
            for (int bj = 0; bj < 2; ++bj)
#pragma unroll
                for (int j = 0; j < 8; ++j) lbv[bj][j] = LB[(colu - 1536) + bj * HALF + lcol + j];
#pragma unroll
            for (int ai = 0; ai < 2; ++ai)
#pragma unroll
                for (int m = 0; m < 4; ++m) { bf16* rowp = base + (size_t)(row0 + ai * HALF + m * 16) * ld + cbase + lcol;
#pragma unroll
                    for (int bj = 0; bj < 2; ++bj) { const f32x4 v0 = acc[ai][bj][m][0], v1 = acc[ai][bj][m][1]; u32x4 w;
                        w.x = cvt_pk_bf16(logf_gate(v0[0], lbv[bj][0]), logf_gate(v0[1], lbv[bj][1])); w.y = cvt_pk_bf16(logf_gate(v0[2], lbv[bj][2]), logf_gate(v0[3], lbv[bj][3]));
                        w.z = cvt_pk_bf16(logf_gate(v1[0], lbv[bj][4]), logf_gate(v1[1], lbv[bj][5])); w.w = cvt_pk_bf16(logf_gate(v1[2], lbv[bj][6]), logf_gate(v1[3], lbv[bj][7]));
                        *(u32x4*)(rowp + bj * bjstep) = w; } }
        } else {
#pragma unroll
            for (int ai = 0; ai < 2; ++ai)
#pragma unroll
                for (int m = 0; m < 4; ++m) { bf16* rowp = base + (size_t)(row0 + ai * HALF + m * 16) * ld + cbase + lcol;
#pragma unroll
                    for (int bj = 0; bj < 2; ++bj) { f32x4 v0 = acc[ai][bj][m][0], v1 = acc[ai][bj][m][1];
                        if (mode == 1) {
#pragma unroll
                            for (int j = 0; j < 4; ++j) { v0[j] = silu_f(v0[j]); v1[j] = silu_f(v1[j]); } }
                        u32x4 w; w.x = cvt_pk_bf16(v0[0], v0[1]); w.y = cvt_pk_bf16(v0[2], v0[3]); w.z = cvt_pk_bf16(v1[0], v1[1]); w.w = cvt_pk_bf16(v1[2], v1[3]);
                        *(u32x4*)(rowp + bj * bjstep) = w; } }
        }
    }
};
struct EpiOutProj {
    static constexpr bool PERM = true; static constexpr bool HAS_PRE = false;
    bf16* XS; const float* g1base; float gsc;
    DI void operator()(const f32x4 (&acc)[2][2][4][2], const Unit& u, int wr, int wc, int fr, int fq) const {
        const int row0 = u.pm * BM + wr * 64 + fr, col0 = u.pn * BM + wc * 32 + 8 * fq;
        const int bb = u.pm / 9, modrow = (u.pm - bb * 9 == 0) ? 16 : bb;
        const float* g = g1base + (size_t)modrow * MODW;
        f32x4 gv[2][2];
#pragma unroll
        for (int bj = 0; bj < 2; ++bj)
#pragma unroll
            for (int n = 0; n < 2; ++n) gv[bj][n] = *(const f32x4*)(g + col0 + bj * HALF + 4 * n) * gsc;
#pragma unroll
        for (int ai = 0; ai < 2; ++ai)
#pragma unroll
            for (int m = 0; m < 4; ++m) { bf16* rowp = XS + (size_t)(row0 + ai * HALF + m * 16) * D + col0;
#pragma unroll
                for (int bj = 0; bj < 2; ++bj) { u32x4* p = (u32x4*)(rowp + bj * HALF); const u32x4 x = *p; const f32x4 a0 = gv[bj][0] * acc[ai][bj][m][0], a1 = gv[bj][1] * acc[ai][bj][m][1];
                    u32x4 o; o.x = cvt_pk_bf16(bflo(x.x) + a0[0], bfhi(x.x) + a0[1]); o.y = cvt_pk_bf16(bflo(x.y) + a0[2], bfhi(x.y) + a0[3]);
                    o.z = cvt_pk_bf16(bflo(x.z) + a1[0], bfhi(x.z) + a1[1]); o.w = cvt_pk_bf16(bflo(x.w) + a1[2], bfhi(x.w) + a1[3]); *p = o; }
                asm volatile("" ::: "memory"); }
    }
};
struct EpiSwiGLU {
    static constexpr bool PERM = true; static constexpr bool HAS_PRE = false;
    bf16* ACT;
    DI void operator()(const f32x4 (&acc)[2][2][4][2], const Unit& u, int wr, int wc, int fr, int fq) const {
        const int row0 = u.pm * BM + wr * 64 + fr, col0 = u.pn * HALF + wc * 32 + 8 * fq;
#pragma unroll
        for (int ai = 0; ai < 2; ++ai)
#pragma unroll
            for (int m = 0; m < 4; ++m) { bf16* rowp = ACT + (size_t)(row0 + ai * HALF + m * 16) * FF + col0;
                const f32x4 g0 = acc[ai][0][m][0], g1 = acc[ai][0][m][1], u0 = acc[ai][1][m][0], u1 = acc[ai][1][m][1];
                u32x4 w; w.x = cvt_pk_bf16(silu_f(g0[0]) * u0[0], silu_f(g0[1]) * u0[1]); w.y = cvt_pk_bf16(silu_f(g0[2]) * u0[2], silu_f(g0[3]) * u0[3]);
                w.z = cvt_pk_bf16(silu_f(g1[0]) * u1[0], silu_f(g1[1]) * u1[1]); w.w = cvt_pk_bf16(silu_f(g1[2]) * u1[2], silu_f(g1[3]) * u1[3]);
                *(u32x4*)rowp = w; }
    }
};
struct EpiDown {
    static constexpr bool PERM = true; static constexpr bool HAS_PRE = true;
    static constexpr int EPT_OFF = 143360;
    bf16* Y; const int* LIST; const float* LISTW; LAS unsigned char* lds;
    DI u32x2 pre_load(const Unit& u, int tid) const { u32x2 r = {0u, 0u}; const int pos = u.r0 + tid;
        if (tid < 256 && pos < u.ne) { r.x = (unsigned)LIST[u.e * T + pos]; r.y = __float_as_uint(LISTW[u.e * T + pos]); } return r; }
    DI void pre_store(int tid, const u32x2& r) const { if (tid < 256) *(LAS u32x2*)(lds + EPT_OFF + tid * 8) = r; }
    DI void operator()(const f32x4 (&acc)[2][2][4][2], const Unit& u, int wr, int wc, int fr, int fq) const {
        const int rl0 = wr * 64 + fr, col0 = u.pn * BM + wc * 32 + 8 * fq;
#pragma unroll
        for (int ai = 0; ai < 2; ++ai)
#pragma unroll
            for (int m = 0; m < 4; ++m) { const int rl = rl0 + ai * HALF + m * 16, pos = u.r0 + rl;
                if (pos < u.ne) { const u32x2 ew = *(const LAS u32x2*)(lds + EPT_OFF + rl * 8); const int ent = (int)ew.x; const float w = __uint_as_float(ew.y);
                    bf16* rowp = Y + ((size_t)(ent & 1) * T + (size_t)(ent >> 1)) * D + col0;
#pragma unroll
                    for (int bj = 0; bj < 2; ++bj) { const f32x4 v0 = acc[ai][bj][m][0] * w, v1 = acc[ai][bj][m][1] * w;
                        u32x4 q; q.x = cvt_pk_bf16(v0[0], v0[1]); q.y = cvt_pk_bf16(v0[2], v0[3]); q.z = cvt_pk_bf16(v1[0], v1[1]); q.w = cvt_pk_bf16(v1[2], v1[3]);
                        *(u32x4*)(rowp + bj * HALF) = q; } } }
    }
};
}

#define XB_TMO      128
#define XB_XCNT(j)  (256  + 64 * (j))
#define XB_XSUB(j)  (1280 + 64 * (j))
#define XB_XGEN(j)  (2304 + 64 * (j))
#define XB_TOP      3328
#define XB_TOPGEN   3392
#define XCD_BAR_WORDS 3456
#define XB_SPIN_CAP (1u << 18)
DI unsigned xb_ld(unsigned* p)              { return __hip_atomic_load(p, __ATOMIC_RELAXED, __HIP_MEMORY_SCOPE_AGENT); }
DI unsigned xb_add(unsigned* p, unsigned v) { return __hip_atomic_fetch_add(p, v, __ATOMIC_RELAXED, __HIP_MEMORY_SCOPE_AGENT); }
DI unsigned xb_xcc_id() { return (unsigned)__builtin_amdgcn_s_getreg((3 << 11) | 20) & 0xFu; }
#define XB_SPIN(cond, bar) do { unsigned _sp = 0; while (cond) { __builtin_amdgcn_s_sleep(1); \
    if ((++_sp & 255u) == 0u) { if (xb_ld(&(bar)[XB_TMO])) break; if (_sp > XB_SPIN_CAP) { atomicAdd(&(bar)[XB_TMO], 1u); break; } } } } while (0)
struct XcdBarrier { unsigned* bar; unsigned x; volatile LAS unsigned* st; };
DI XcdBarrier xcd_barrier_post(unsigned* bar, volatile LAS unsigned* st, bool leader) {
    XcdBarrier b; b.bar = bar; b.x = xb_xcc_id(); b.st = st;
    if (leader) (void)xb_add(&bar[XB_XCNT(b.x)], 1u);
    return b;
}
DI void xcd_barrier_complete(unsigned* bar, unsigned x, unsigned& nloc, unsigned& nx) {
    const unsigned G = gridDim.x * gridDim.y * gridDim.z;
    unsigned sum, cnt, mine, sp = 0u;
    for (;;) {
        sum = 0u; cnt = 0u; mine = 0u;
#pragma unroll
        for (unsigned j = 0; j < 16; ++j) { const unsigned c = xb_ld(&bar[XB_XCNT(j)]); sum += c; cnt += (c > 0u) ? 1u : 0u; mine = (j == x) ? c : mine; }
        if (sum == G) break;
        __builtin_amdgcn_s_sleep(1);
        if ((++sp & 255u) == 0u) { if (xb_ld(&bar[XB_TMO])) break; if (sp > XB_SPIN_CAP) { atomicAdd(&bar[XB_TMO], 1u); break; } }
    }
    nloc = mine > 0u ? mine : 1u; nx = cnt > 0u ? cnt : 1u;
}
DI void xcd_barrier(const XcdBarrier& b, bool leader) {
    asm volatile("s_waitcnt vmcnt(0)" ::: "memory");
    __syncthreads();
    if (leader) {
        unsigned* bar = b.bar;
        __builtin_amdgcn_s_waitcnt(0);
        unsigned nloc = b.st[0], nx = b.st[1];
        if (nloc == 0u) { xcd_barrier_complete(bar, b.x, nloc, nx); b.st[0] = nloc; b.st[1] = nx; }
        const unsigned old = xb_add(&bar[XB_XSUB(b.x)], 1u);
        const unsigned gen = old / nloc;
        if (old + 1u == (gen + 1u) * nloc) {
            __builtin_amdgcn_fence(__ATOMIC_RELEASE, "agent");
            asm volatile("s_waitcnt vmcnt(0)" ::: "memory");
            const unsigned og = xb_add(&bar[XB_TOP], 1u);
            const unsigned tg = og / nx;
            if (og + 1u == (tg + 1u) * nx) xb_add(&bar[XB_TOPGEN], 1u);
            else XB_SPIN(xb_ld(&bar[XB_TOPGEN]) == tg, bar);
            __builtin_amdgcn_fence(__ATOMIC_ACQUIRE, "agent");
            xb_add(&bar[XB_XGEN(b.x)], 1u);
            asm volatile("s_waitcnt vmcnt(0)" ::: "memory");
        } else {
            XB_SPIN(xb_ld(&bar[XB_XGEN(b.x)]) == gen, bar);
            __builtin_amdgcn_fence(__ATOMIC_ACQUIRE, "agent");
            asm volatile("s_waitcnt vmcnt(0)" ::: "memory");
        }
    }
    __syncthreads();
}

struct Frame {
    LAS unsigned char* lds;
    gu32* ctl;
    int tid, lane, wave, G, bx, dry;
    int wsg;
    const float *x, *c, *ctx, *c_ctx, *w_mod, *b_mod, *norm1_w, *norm2_w, *w_in, *w_out, *hg_lb, *hg_norm_w, *dn_conv_w, *dn_a_log, *dn_dt_bias, *dn_norm_w,
                *w_group, *b_group, *w_expert, *b_expert, *w_gate, *w_up, *w_down, *final_norm_w;
    float* out;
    float *MOD, *LB, *CA, *CH, *BETA, *LOGA, *CUM, *LISTW;
    bf16* XS;
    int* LIST;
    bf16 *WIN, *WOUT, *HBQ, *PHG, *PZ, *PREP, *Wb, *Ub, *QKN, *QKDb;
};

struct TrItem { const float* W; bf16* WT; int ldW, Kp, k0, n0, dst_row0; };
DI void transpose_load(float (&tv)[32], const TrItem& I, int lane) {
#pragma unroll
    for (int i = 0; i < 32; ++i) tv[i] = I.W[(size_t)(I.k0 + 2 * i + (lane >> 5)) * I.ldW + I.n0 + (lane & 31)];
}
DI void transpose_store(const float (&tv)[32], const TrItem& I, LAS float* scr, int lane) {
#pragma unroll
    for (int i = 0; i < 32; ++i) scr[(2 * i + (lane >> 5)) * 33 + (lane & 31)] = tv[i];
    LDS_WAIT(); asm volatile("" ::: "memory");
    const int c = lane & 7;
#pragma unroll
    for (int j = 0; j < 4; ++j) { const int n = (lane >> 3) + 8 * j; const LAS float* s = scr + (8 * c) * 33 + n;
        u32x4 o; o.x = cvt_pk_bf16(s[0 * 33], s[1 * 33]); o.y = cvt_pk_bf16(s[2 * 33], s[3 * 33]); o.z = cvt_pk_bf16(s[4 * 33], s[5 * 33]); o.w = cvt_pk_bf16(s[6 * 33], s[7 * 33]);
        *(u32x4*)(I.WT + (size_t)(I.dst_row0 + n) * I.Kp + I.k0 + 8 * c) = o; }
    LDS_WAIT(); asm volatile("" ::: "memory");
}
#define TRANSPOSE_LOOP(first, N, stride, DEC) do { int it_ = (first); if (it_ < (N)) { float tva_[32], tvb_[32]; TrItem ia_ = DEC(it_), ib_ = ia_; transpose_load(tva_, ia_, F.lane); \
        for (;;) { int nx_ = it_ + (stride); const bool h1_ = nx_ < (N); if (h1_) { ib_ = DEC(nx_); transpose_load(tvb_, ib_, F.lane); } \
            transpose_store(tva_, ia_, scr, F.lane); if (!h1_) break; \
            it_ = nx_ + (stride); const bool h2_ = it_ < (N); if (h2_) { ia_ = DEC(it_); transpose_load(tva_, ia_, F.lane); } \
            transpose_store(tvb_, ib_, scr, F.lane); if (!h2_) break; } } } while (0)

struct Args { const float* in[24]; float* out; unsigned char* ws; int ph_lo, ph_hi, bar_slot; };
typedef const __attribute__((address_space(4))) Args* KArgs;
DI void make_frame(Frame& F) {
    extern __shared__ __attribute__((aligned(16))) unsigned char lds_raw[];
    KArgs ka = (KArgs)__builtin_amdgcn_kernarg_segment_ptr(); asm volatile("" : "+s"(ka));
    int wv_ = F.wsg; asm volatile("" : "+s"(wv_));
    unsigned z_ = 0u; asm volatile("" : "+v"(z_));
    int t = wv_ * 64 + (int)__builtin_amdgcn_mbcnt_hi(~0u, __builtin_amdgcn_mbcnt_lo(~0u, z_)); asm volatile("" : "+v"(t));
    { LAS unsigned char* lb = (LAS unsigned char*)lds_raw; asm volatile("" : "+s"(lb)); F.lds = lb; }
    F.tid = t; F.lane = t & 63; F.wave = wv_;
    { int g = gridDim.x, b = blockIdx.x; asm volatile("" : "+s"(g), "+s"(b)); F.G = g; F.bx = b; }
    F.dry = (ka->ph_hi >> 16) & 3;
    unsigned char* ws = ka->ws;
    F.ctl = (gu32*)(ws + WS_CTL);
    F.x = ka->in[0]; F.c = ka->in[1]; F.ctx = ka->in[2]; F.c_ctx = ka->in[3]; F.w_mod = ka->in[4]; F.b_mod = ka->in[5]; F.norm1_w = ka->in[6]; F.norm2_w = ka->in[7];
    F.w_in = ka->in[8]; F.w_out = ka->in[9]; F.hg_lb = ka->in[10]; F.hg_norm_w = ka->in[11]; F.dn_conv_w = ka->in[12]; F.dn_a_log = ka->in[13]; F.dn_dt_bias = ka->in[14]; F.dn_norm_w = ka->in[15];
    F.w_group = ka->in[16]; F.b_group = ka->in[17]; F.w_expert = ka->in[18]; F.b_expert = ka->in[19]; F.w_gate = ka->in[20]; F.w_up = ka->in[21]; F.w_down = ka->in[22]; F.final_norm_w = ka->in[23];
    F.out = ka->out;
    F.MOD = (float*)(ws + WS_MOD); F.LB = (float*)(ws + WS_LB); F.CA = (float*)(ws + WS_CA); F.CH = (float*)(ws + WS_CH); F.BETA = (float*)(ws + WS_BETA); F.LOGA = (float*)(ws + WS_LOGA); F.CUM = (float*)(ws + WS_CUM); F.LIST = (int*)(ws + WS_LIST); F.LISTW = (float*)(ws + WS_LISTW);
    F.XS = (bf16*)(ws + WS_XS); F.WIN = (bf16*)(ws + WS_WIN); F.WOUT = (bf16*)(ws + WS_WOUT); F.HBQ = (bf16*)(ws + WS_HBQ); F.PHG = (bf16*)(ws + WS_PHG); F.PZ = (bf16*)(ws + WS_PZ); F.PREP = (bf16*)(ws + WS_PREP);
    F.Wb = (bf16*)(ws + WS_XS + XSLOT_W); F.Ub = (bf16*)(ws + WS_PREP + PREP_U); F.QKN = (bf16*)(ws + WS_HBQ); F.QKDb = (bf16*)(ws + WS_QKD);
}
DI void row_info(int t, int& b, int& r, int& modrow) { b = t / RPB; r = t - b * RPB; modrow = (r < CTXL) ? 16 : b; }

DI void load_xrow(const Frame& F, int l, int t, int b, int r, int modrow, f32x4 (&v)[4]) {
    if (l == 0) {
        const float* src = (r < CTXL) ? F.ctx + ((size_t)b * CTXL + r) * D : F.x + ((size_t)b * SEQ + (r - CTXL)) * D;
#pragma unroll
        for (int j = 0; j < 4; ++j) v[j] = ((const f32x4*)src)[F.lane + 64 * j];
    } else {
        const u32x2* xs = (const u32x2*)(F.XS + (size_t)t * D);
        const u32x2* y0 = (const u32x2*)(F.PHG + (size_t)t * D); const u32x2* y1 = (const u32x2*)(F.PHG + ((size_t)T + t) * D);
        const f32x4* g2 = (const f32x4*)(F.MOD + ((size_t)(l - 1) * 17 + modrow) * MODW + 5 * D);
#pragma unroll
        for (int j = 0; j < 4; ++j) { const int e = F.lane + 64 * j; const f32x4 g = g2[e]; const u32x2 xv = xs[e], a = y0[e], c = y1[e];
            f32x4 y; y[0] = bflo(a.x) + bflo(c.x); y[1] = bfhi(a.x) + bfhi(c.x); y[2] = bflo(a.y) + bflo(c.y); y[3] = bfhi(a.y) + bfhi(c.y);
            f32x4 x; x[0] = bflo(xv.x); x[1] = bfhi(xv.x); x[2] = bflo(xv.y); x[3] = bfhi(xv.y);
            v[j] = x + g * y; }
    }
}
struct RowRaw { f32x4 x[4]; u32x2 c[4]; };
DI void row_issue(const Frame& F, int l, int t, RowRaw& R) {
    int b, r, modrow; row_info(t, b, r, modrow);
    if (l == 0) {
        const float* src = (r < CTXL) ? F.ctx + ((size_t)b * CTXL + r) * D : F.x + ((size_t)b * SEQ + (r - CTXL)) * D;
#pragma unroll
        for (int j = 0; j < 4; ++j) R.x[j] = ((const f32x4*)src)[F.lane + 64 * j];
    } else {
        const u32x2* xs = (const u32x2*)(F.XS + (size_t)t * D);
        const u32x2* y0 = (const u32x2*)(F.PHG + (size_t)t * D); const u32x2* y1 = (const u32x2*)(F.PHG + ((size_t)T + t) * D);
#pragma unroll
        for (int j = 0; j < 4; ++j) { const int e = F.lane + 64 * j; const u32x2 xv = xs[e], a = y0[e];
            R.x[j][0] = __uint_as_float(xv.x); R.x[j][1] = __uint_as_float(xv.y); R.x[j][2] = __uint_as_float(a.x); R.x[j][3] = __uint_as_float(a.y); R.c[j] = y1[e]; }
    }
}
DI void row_finish(const Frame& F, int l, int modrow, const RowRaw& R, f32x4 (&v)[4]) {
    if (l == 0) {
#pragma unroll
        for (int j = 0; j < 4; ++j) v[j] = R.x[j];
    } else {
        const f32x4* g2 = (const f32x4*)(F.MOD + ((size_t)(l - 1) * 17 + modrow) * MODW + 5 * D);
#pragma unroll
        for (int j = 0; j < 4; ++j) { const u32x2 c = R.c[j]; const unsigned x0 = __float_as_uint(R.x[j][0]), x1 = __float_as_uint(R.x[j][1]), a0 = __float_as_uint(R.x[j][2]), a1 = __float_as_uint(R.x[j][3]);
            f32x4 y; y[0] = bflo(a0) + bflo(c.x); y[1] = bfhi(a0) + bfhi(c.x); y[2] = bflo(a1) + bflo(c.y); y[3] = bfhi(a1) + bfhi(c.y);
            f32x4 x; x[0] = bflo(x0); x[1] = bfhi(x0); x[2] = bflo(x1); x[3] = bfhi(x1);
            v[j] = x + g2[F.lane + 64 * j] * y; }
    }
}
DI float row_rstd(const f32x4 (&v)[4]) {
    float s = 0.f;
#pragma unroll
    for (int j = 0; j < 4; ++j) s += (v[j][0] * v[j][0] + v[j][1] * v[j][1]) + (v[j][2] * v[j][2] + v[j][3] * v[j][3]);
    return 1.0f / sqrtf(wave_sum(s) * (1.0f / D) + EPS);
}
DI float reduce16(float (&v)[16], int lane) {
#pragma unroll
    for (int i = 0; i < 8; ++i) v[i] = pair32(v[i], v[i + 8]);
#pragma unroll
    for (int i = 0; i < 4; ++i) { const bool hi = (lane & 16) != 0; const float snd = hi ? v[i] : v[i + 4], keep = hi ? v[i + 4] : v[i]; v[i] = keep + swz<16>(snd); }
#pragma unroll
    for (int i = 0; i < 2; ++i) { const bool hi = (lane & 8) != 0; const float snd = hi ? v[i] : v[i + 2], keep = hi ? v[i + 2] : v[i]; v[i] = keep + swz<8>(snd); }
    { const bool hi = (lane & 4) != 0; const float snd = hi ? v[0] : v[1], keep = hi ? v[1] : v[0]; v[0] = keep + swz<4>(snd); }
    v[0] += swz<2>(v[0]); v[0] += swz<1>(v[0]);
    return v[0];
}

DI void phase_prologue(Frame& F) {
    make_frame(F);
    LAS float* sc = (LAS float*)F.lds;
    LAS float* red = (LAS float*)(F.lds + 17 * 1024 * 4);
    for (int i = F.tid; i < 17 * D; i += 512) { const int r = i / D, k = i - r * D; const float cv = (r < 16) ? F.c[r * D + k] : F.c_ctx[k]; sc[i] = silu_f(cv); }
    __syncthreads();
    const int kq = F.tid >> 6, nn = F.tid & 63;
    for (int it = F.bx; it < DEPTH * 96; it += F.G) {
        const int l = it / 96, n0 = (it - l * 96) * 64;
        float acc[17];
#pragma unroll
        for (int r = 0; r < 17; ++r) acc[r] = 0.f;
        const float* wp = F.w_mod + ((size_t)l * D + kq * 128) * MODW + n0 + nn;
#pragma unroll 4
        for (int k = 0; k < 128; ++k) { const float w = wp[(size_t)k * MODW];
#pragma unroll
            for (int r = 0; r < 17; ++r) acc[r] += sc[r * D + kq * 128 + k] * w; }
#pragma unroll
        for (int r = 0; r < 17; ++r) red[(kq * 17 + r) * 64 + nn] = acc[r];
        __syncthreads();
        for (int i = F.tid; i < 17 * 64; i += 512) { const int r = i >> 6, n = i & 63; float s = F.b_mod[l * MODW + n0 + n];
#pragma unroll
            for (int q = 0; q < 8; ++q) s += red[(q * 17 + r) * 64 + n];
            F.MOD[((size_t)l * 17 + r) * MODW + n0 + n] = s; }
        __syncthreads();
    }
    if (F.bx == 0) {
        for (int i = F.tid; i < 2 * 512; i += 512) {
            float xv[DEPTH], m = -1e30f;
#pragma unroll
            for (int l = 0; l < DEPTH; ++l) { xv[l] = F.hg_lb[l * 1024 + i]; m = fmaxf(m, xv[l]); }
            float s = 0.f;
#pragma unroll
            for (int l = 0; l < DEPTH; ++l) { xv[l] = expf(xv[l] - m); s += xv[l]; }
            float cum = 0.f, c0 = 0.f;
#pragma unroll
            for (int l = 0; l < DEPTH; ++l) { cum += xv[l] / s; if (l == 0) c0 = cum; F.LB[l * 1024 + i] = cum - c0; }
        }
    }
}

constexpr int HW_WTS = 2064;
constexpr int AW_WT = 0, AW_WSC = 32 * HW_WTS, AW_SH = AW_WSC + 2 * 1024 * 4, AW_G2 = AW_SH + 2 * 1024 * 4, AW_LGP = AW_G2 + 2 * 1024 * 4, AW_SSP = AW_LGP + 8 * 16 * 17 * 4;
DI void phase_consts(Frame& F) {
    make_frame(F);
    const int gw = F.bx * 8 + F.wave, NGW = F.G * 8;
    for (int task = gw; task < DEPTH * 17; task += NGW) {
        const int l = task / 17, m = task - l * 17;
        const float* sh1 = F.MOD + ((size_t)l * 17 + m) * MODW; const float* sh2 = sh1 + 3 * D;
        float ca[16], ce[16], cg[4];
#pragma unroll
        for (int q = 0; q < 16; ++q) { ca[q] = 0.f; ce[q] = 0.f; }
#pragma unroll
        for (int q = 0; q < 4; ++q) cg[q] = 0.f;
        for (int kk = 0; kk < 16; ++kk) { const int k = F.lane * 16 + kk; const float s1 = sh1[k], s2 = sh2[k];
            const f32x4* wa = (const f32x4*)(F.w_in + ((size_t)l * D + k) * INC + NP); const f32x4* we = (const f32x4*)(F.w_expert + ((size_t)l * D + k) * 16); const f32x4 wg = *(const f32x4*)(F.w_group + ((size_t)l * D + k) * 4);
#pragma unroll
            for (int q4 = 0; q4 < 4; ++q4) { const f32x4 a = wa[q4], e = we[q4];
#pragma unroll
                for (int j = 0; j < 4; ++j) { ca[4 * q4 + j] += s1 * a[j]; ce[4 * q4 + j] += s2 * e[j]; } }
#pragma unroll
            for (int j = 0; j < 4; ++j) cg[j] += s2 * wg[j]; }
#pragma unroll
        for (int q = 0; q < 16; ++q) { const float a = wave_sum(ca[q]), e = wave_sum(ce[q]); if (F.lane == 0) { F.CA[(l * 17 + m) * 16 + q] = a; F.CH[(l * 17 + m) * 20 + 4 + q] = e + F.b_expert[l * 16 + q]; } }
#pragma unroll
        for (int q = 0; q < 4; ++q) { const float gq = wave_sum(cg[q]); if (F.lane == 0) F.CH[(l * 17 + m) * 20 + q] = gq + F.b_group[l * 4 + q]; }
    }
}

constexpr size_t XO_WGU = 0, XO_WDN = 32 * MiB, XO_WOUT1 = 48 * MiB;
DI bf16* wout_buf(const Frame& F, int l) { return (l & 1) ? (bf16*)((char*)F.out + XO_WOUT1) : F.WOUT; }
DI void inout_weight_transposes(Frame& F, int l, int rank, int nblk) {
    LAS float* scr = (LAS float*)(F.lds + F.wave * 8448);
    const float* win = F.w_in + (size_t)l * D * INC; const float* wout = F.w_out + (size_t)l * D * D;
    bf16* WO = wout_buf(F, l);
    constexpr int I_IN = 16 * (NP / 32), I_OUT = 16 * (D / 32);
    auto dec = [&](int it) -> TrItem {
        if (it < I_IN) { const int nblk_ = NP / 32, kb = it / nblk_, nb = it - kb * nblk_; return TrItem{win, F.WIN, INC, D, 64 * kb, 32 * nb, 32 * nb}; }
        const int r = it - I_IN, nblk_ = D / 32, kb = r / nblk_, nb = r - kb * nblk_; return TrItem{wout, WO, D, D, 64 * kb, 32 * nb, 32 * nb}; };
    TRANSPOSE_LOOP(rank * 8 + F.wave, I_IN + I_OUT, nblk * 8, dec);
}

DI void phase_A(Frame& F, int l) {
    make_frame(F);
    const int gw = F.bx * 8 + F.wave, NGW = F.G * 8;
    if (l == 0) inout_weight_transposes(F, 0, F.bx, F.G);
    __syncthreads();
    LAS unsigned char* L = F.lds;
    for (int k = F.tid; k < D; k += 512) {
        const f32x4* wa = (const f32x4*)(F.w_in + ((size_t)l * D + k) * INC + NP);
#pragma unroll
        for (int q4 = 0; q4 < 4; ++q4) { const f32x4 e4 = wa[q4];
#pragma unroll
            for (int j = 0; j < 4; ++j) { const unsigned hi = cvtpk(e4[j], 0.f) & 0xffffu; const unsigned lo = cvtpk(e4[j] - __uint_as_float(hi << 16), 0.f) & 0xffffu;
                *(LAS bf16*)(L + AW_WT + (4 * q4 + j) * HW_WTS + k * 2) = (bf16)hi; *(LAS bf16*)(L + AW_WT + (16 + 4 * q4 + j) * HW_WTS + k * 2) = (bf16)lo; } }
    }
    constexpr int RPWA = T / 2048;
    const int bblk = (F.bx * 8 * RPWA) / RPB;
    const float* n1 = F.norm1_w + l * D;
    for (int i = F.tid; i < 2 * D; i += 512) { const int cls = i >> 10, k = i & 1023; const int mr = cls ? 16 : bblk; const float* md = F.MOD + ((size_t)l * 17 + mr) * MODW;
        *(LAS float*)(L + AW_WSC + i * 4) = n1[k] * (md[D + k] + 1.0f); *(LAS float*)(L + AW_SH + i * 4) = md[k];
        *(LAS float*)(L + AW_G2 + i * 4) = l > 0 ? F.MOD[((size_t)(l - 1) * 17 + mr) * MODW + 5 * D + k] : 0.f; }
    __syncthreads();
    static_assert(RPWA == 18, "phase A row split");
    const int tbeg = gw * RPWA;
#define A_LD(dst, gq) do { _Pragma("unroll") for (int q_ = 0; q_ < 4; ++q_) { const int ks = 4 * (gq) + q_; \
            if (l > 0) { dst[q_][0] = *(const u32x4*)(xsr + 32 * ks); dst[q_][1] = *(const u32x4*)(y0r + 32 * ks); dst[q_][2] = *(const u32x4*)(y1r + 32 * ks); } \
            else { dst[q_][1] = *(const u32x4*)(xf + 32 * ks); dst[q_][2] = *(const u32x4*)(xf + 32 * ks + 4); } } } while (0)
#define A_PROC(src, gq) do { _Pragma("unroll") for (int q_ = 0; q_ < 4; ++q_) { const int ks = 4 * (gq) + q_; float v_[8]; \
            if (l == 0) { const u32x4 xa_ = src[q_][1], xb_ = src[q_][2]; v_[0] = __uint_as_float(xa_.x); v_[1] = __uint_as_float(xa_.y); v_[2] = __uint_as_float(xa_.z); v_[3] = __uint_as_float(xa_.w); \
                v_[4] = __uint_as_float(xb_.x); v_[5] = __uint_as_float(xb_.y); v_[6] = __uint_as_float(xb_.z); v_[7] = __uint_as_float(xb_.w); } \
            else { const u32x4 x = src[q_][0]; v_[0] = bflo(x.x); v_[1] = bfhi(x.x); v_[2] = bflo(x.y); v_[3] = bfhi(x.y); v_[4] = bflo(x.z); v_[5] = bfhi(x.z); v_[6] = bflo(x.w); v_[7] = bfhi(x.w); } \
            if (l > 0) { const u32x4 ya = src[q_][1], yc = src[q_][2]; const f32x4 ga = *(const LAS f32x4*)(g2p + ks * 128), gb = *(const LAS f32x4*)(g2p + ks * 128 + 16); \
                v_[0] += ga[0] * (bflo(ya.x) + bflo(yc.x)); v_[1] += ga[1] * (bfhi(ya.x) + bfhi(yc.x)); v_[2] += ga[2] * (bflo(ya.y) + bflo(yc.y)); v_[3] += ga[3] * (bfhi(ya.y) + bfhi(yc.y)); \
                v_[4] += gb[0] * (bflo(ya.z) + bflo(yc.z)); v_[5] += gb[1] * (bfhi(ya.z) + bfhi(yc.z)); v_[6] += gb[2] * (bflo(ya.w) + bflo(yc.w)); v_[7] += gb[3] * (bfhi(ya.w) + bfhi(yc.w)); } \
            u32x4 xo; xo.x = cvtpk(v_[0], v_[1]); xo.y = cvtpk(v_[2], v_[3]); xo.z = cvtpk(v_[4], v_[5]); xo.w = cvtpk(v_[6], v_[7]); if (st) *(u32x4*)(xsw + 32 * ks) = xo; if (KEEP) src[q_][0] = xo; \
            _Pragma("unroll") for (int j_ = 0; j_ < 8; ++j_) ss8[j_] += v_[j_] * v_[j_]; \
            asm volatile("" : "+v"(ss8[0]), "+v"(ss8[1]), "+v"(ss8[2]), "+v"(ss8[3]), "+v"(ss8[4]), "+v"(ss8[5]), "+v"(ss8[6]), "+v"(ss8[7]));     \
            const f32x4 w0 = *(const LAS f32x4*)(wscp + ks * 128), w1 = *(const LAS f32x4*)(wscp + ks * 128 + 16); \
            const float h0 = v_[0] * w0[0], h1 = v_[1] * w0[1], h2 = v_[2] * w0[2], h3 = v_[3] * w0[3], h4 = v_[4] * w1[0], h5 = v_[5] * w1[1], h6 = v_[6] * w1[2], h7 = v_[7] * w1[3]; \
            u32x4 ah; ah.x = cvtpk(h0, h1); ah.y = cvtpk(h2, h3); ah.z = cvtpk(h4, h5); ah.w = cvtpk(h6, h7); \
            const bf16x8 Ah = __builtin_bit_cast(bf16x8, ah); \
            const bf16x8 Al = pack8(h0 - bflo(ah.x), h1 - bfhi(ah.x), h2 - bflo(ah.y), h3 - bfhi(ah.y), h4 - bflo(ah.z), h5 - bfhi(ah.z), h6 - bflo(ah.w), h7 - bfhi(ah.w)); \
            const bf16x8 B0 = *(const LAS bf16x8*)(b0p + ks * 64), B1 = *(const LAS bf16x8*)(b1p + ks * 64); \
            acc = MFMA16(Ah, B0, acc); acc = MFMA16(Al, B0, acc); acc = MFMA16(Ah, B1, acc); } } while (0)
#define A_LD2(dst, gq) do { _Pragma("unroll") for (int q_ = 0; q_ < 4; ++q_) dst[q_][0] = *(const u32x4*)(xsr + 32 * (4 * (gq) + q_)); } while (0)
#define A_OUT(src, gq) do { _Pragma("unroll") for (int q_ = 0; q_ < 4; ++q_) { const int ks = 4 * (gq) + q_; \
            const u32x4 x = src[q_][0]; const f32x4 w0 = *(const LAS f32x4*)(wscp + ks * 128), w1 = *(const LAS f32x4*)(wscp + ks * 128 + 16), s0 = *(const LAS f32x4*)(shp + ks * 128), s1 = *(const LAS f32x4*)(shp + ks * 128 + 16); \
            u32x4 o; o.x = cvtpk(bflo(x.x) * w0[0] * rstd + s0[0], bfhi(x.x) * w0[1] * rstd + s0[1]); o.y = cvtpk(bflo(x.y) * w0[2] * rstd + s0[2], bfhi(x.y) * w0[3] * rstd + s0[3]); \
            o.z = cvtpk(bflo(x.z) * w1[0] * rstd + s1[0], bfhi(x.z) * w1[1] * rstd + s1[1]); o.w = cvtpk(bflo(x.w) * w1[2] * rstd + s1[2], bfhi(x.w) * w1[3] * rstd + s1[3]); \
            *(u32x4*)(ho + 32 * ks) = o; } } while (0)
#define A_THIN(accv, TROW) do { const int dir = (c >> 2) & 1, hh = c & 3; \
            const float alog = -__expf(F.dn_a_log[(l * 2 + dir) * 4 + hh]), dtb = F.dn_dt_bias[(l * 2 + dir) * 4 + hh]; \
            _Pragma("unroll") for (int j = 0; j < 4; ++j) { const int row = 4 * g + j; const float rs = lane_get(rstd, row); \
                const int t2 = TROW(row); int b2, r2, m2; row_info(t2, b2, r2, m2); \
                const float val = accv[j] * rs + F.CA[(l * 17 + m2) * 16 + c]; \
                if (c < 8) F.BETA[((size_t)dir * T + t2) * 4 + hh] = sigmoid_f(val); else F.LOGA[((size_t)dir * T + t2) * 4 + hh] = alog * softplus_f(val + dtb); } } while (0)
#define SBA() __builtin_amdgcn_sched_barrier(0)
    {
        constexpr bool KEEP = false;
        int c_o = F.lane & 15, g_o = F.lane >> 4; asm volatile("" : "+v"(c_o), "+v"(g_o)); const int c = c_o, g = g_o;
        const int t = tbeg + c;
        int b, r, modrow; row_info(t, b, r, modrow); const int cls = modrow == 16 ? 1 : 0;
        const bf16* xsr = F.XS + (size_t)t * D + 8 * g; const bf16* y0r = F.PHG + (size_t)t * D + 8 * g; const bf16* y1r = F.PHG + ((size_t)T + t) * D + 8 * g;
        bf16* xsw = F.XS + (size_t)t * D + 8 * g; bf16* ho = F.HBQ + (size_t)t * D + 8 * g;
        const float* xf = (r < CTXL ? F.ctx + ((size_t)b * CTXL + r) * D : F.x + ((size_t)b * SEQ + (r - CTXL)) * D) + 8 * g;
        const LAS unsigned char* wscp = L + AW_WSC + (cls * D + 8 * g) * 4; const LAS unsigned char* shp = L + AW_SH + (cls * D + 8 * g) * 4; const LAS unsigned char* g2p = L + AW_G2 + (cls * D + 8 * g) * 4;
        const LAS unsigned char* b0p = L + AW_WT + c * HW_WTS + 8 * g * 2; const LAS unsigned char* b1p = b0p + 16 * HW_WTS;
        f32x4 acc = {0.f, 0.f, 0.f, 0.f}; float ss8[8] = {0.f, 0.f, 0.f, 0.f, 0.f, 0.f, 0.f, 0.f};
        const bool st = !F.dry;
        u32x4 ra[4][3], rb[4][3];
        A_LD(ra, 0); SBA();
        A_LD(rb, 1); SBA(); A_PROC(ra, 0); SBA();
        A_LD(ra, 2); SBA(); A_PROC(rb, 1); SBA();
        A_LD(rb, 3); SBA(); A_PROC(ra, 2); SBA();
        A_LD(ra, 4); SBA(); A_PROC(rb, 3); SBA();
        A_LD(rb, 5); SBA(); A_PROC(ra, 4); SBA();
        A_LD(ra, 6); SBA(); A_PROC(rb, 5); SBA();
        A_LD(rb, 7); SBA(); A_PROC(ra, 6); SBA();
        A_PROC(rb, 7); SBA();
        float ss = ((ss8[0] + ss8[1]) + (ss8[2] + ss8[3])) + ((ss8[4] + ss8[5]) + (ss8[6] + ss8[7])); ss += swz<16>(ss); ss = add_x32(ss);
        const float rstd = 1.0f / sqrtf(ss * (1.0f / D) + EPS);
#define A_TROW1(row) (tbeg + (row))
        A_THIN(acc, A_TROW1);
#undef A_TROW1
        asm volatile("s_waitcnt vmcnt(0)" ::: "memory");
        A_LD2(ra, 0); A_LD2(rb, 1); SBA(); A_OUT(ra, 0); SBA();
        A_LD2(ra, 2); SBA(); A_OUT(rb, 1); SBA();
        A_LD2(rb, 3); SBA(); A_OUT(ra, 2); SBA();
        A_LD2(ra, 4); SBA(); A_OUT(rb, 3); SBA();
        A_LD2(rb, 5); SBA(); A_OUT(ra, 4); SBA();
        A_LD2(ra, 6); SBA(); A_OUT(rb, 5); SBA();
        A_LD2(rb, 7); SBA(); A_OUT(ra, 6); SBA();
        A_OUT(rb, 7);
    }
    {
        constexpr bool KEEP = true;
        int c_o = F.lane & 15, g_o = F.lane >> 4; asm volatile("" : "+v"(c_o), "+v"(g_o)); const int c = c_o, g = g_o;
        const int w = F.wave;
#define A_TROW2(row) ((F.bx * 8 + ((row) >> 1)) * RPWA + 16 + ((row) & 1))
        const int t = A_TROW2(c);
        int b, r, modrow; row_info(t, b, r, modrow); const int cls = modrow == 16 ? 1 : 0;
        const int ko = 128 * w + 8 * g;
        const bf16* xsr = F.XS + (size_t)t * D + ko; const bf16* y0r = F.PHG + (size_t)t * D + ko; const bf16* y1r = F.PHG + ((size_t)T + t) * D + ko;
        bf16* xsw = F.XS + (size_t)t * D + ko; bf16* ho = F.HBQ + (size_t)t * D + ko;
        const float* xf = (r < CTXL ? F.ctx + ((size_t)b * CTXL + r) * D : F.x + ((size_t)b * SEQ + (r - CTXL)) * D) + ko;
        const LAS unsigned char* wscp = L + AW_WSC + (cls * D + ko) * 4; const LAS unsigned char* shp = L + AW_SH + (cls * D + ko) * 4; const LAS unsigned char* g2p = L + AW_G2 + (cls * D + ko) * 4;
        const LAS unsigned char* b0p = L + AW_WT + c * HW_WTS + ko * 2; const LAS unsigned char* b1p = b0p + 16 * HW_WTS;
        f32x4 acc = {0.f, 0.f, 0.f, 0.f}; float ss8[8] = {0.f, 0.f, 0.f, 0.f, 0.f, 0.f, 0.f, 0.f};
        const bool st = !F.dry;
        u32x4 ra[4][3];
        A_LD(ra, 0); SBA(); A_PROC(ra, 0); SBA();
        float ss = ((ss8[0] + ss8[1]) + (ss8[2] + ss8[3])) + ((ss8[4] + ss8[5]) + (ss8[6] + ss8[7])); ss += swz<16>(ss); ss = add_x32(ss);
        LAS float* LGP = (LAS float*)(L + AW_LGP); LAS float* SSP = (LAS float*)(L + AW_SSP);
#pragma unroll
        for (int j = 0; j < 4; ++j) LGP[w * 16 * 17 + (4 * g + j) * 17 + c] = acc[j];
        if (g == 0) SSP[w * 16 + c] = ss;
        __syncthreads();
        float sst = 0.f;
#pragma unroll
        for (int w2 = 0; w2 < 8; ++w2) sst += SSP[w2 * 16 + c];
        const float rstd = 1.0f / sqrtf(sst * (1.0f / D) + EPS);
        A_OUT(ra, 0);
        if (w == 0) {
            f32x4 at = {0.f, 0.f, 0.f, 0.f};
#pragma unroll
            for (int w2 = 0; w2 < 8; ++w2)
#pragma unroll
                for (int j = 0; j < 4; ++j) at[j] += LGP[w2 * 16 * 17 + (4 * g + j) * 17 + c];
            A_THIN(at, A_TROW2);
        }
#undef A_TROW2
    }
#undef A_LD
#undef A_PROC
#undef A_LD2
#undef A_OUT
#undef A_THIN
#undef SBA
}

DI int step_row(int dir, int i) { return dir == 0 ? i : (i < CTXL ? CTXL - 1 - i : (RPB + CTXL - 1) - i); }

constexpr int RS = 272;
constexpr int HIMG = 32 * RS;
constexpr int H_RAWQ = 0, H_RAWF = 2 * HIMG, H_V = 4 * HIMG, H_QT = 6 * HIMG, H_KB = 8 * HIMG, H_KT = 10 * HIMG, H_OST = 12 * HIMG, H_G = 14 * HIMG;
static_assert(H_G + 1024 <= RING_BYTES, "HGRN2 LDS map");
DI void hg_unit(Frame& F, int unit) {
    make_frame(F);
    const int b = unit >> 3, h = (unit >> 1) & 3, dir = unit & 1;
    LAS unsigned char* L = F.lds;
    const int lane = F.lane, w = F.wave, c = lane & 15, g = lane >> 4, q4 = (lane & 15) >> 2, p = lane & 3;
    const int srow = F.tid >> 4, c8 = (F.tid & 15) * 8;
    const int d0 = 16 * w, e0 = 16 * w;
    bf16* Pb = F.PHG + phg_idx(b, h, 0);
    bf16x8 LT[2];
#pragma unroll
    for (int nt = 0; nt < 2; ++nt)
#pragma unroll
        for (int j = 0; j < 8; ++j) LT[nt][j] = (8 * g + j <= c + 16 * nt) ? (short)0x3F80 : (short)0;
    f32x4 S[8];
#pragma unroll
    for (int dt = 0; dt < 8; ++dt) S[dt] = (f32x4){0.f, 0.f, 0.f, 0.f};
    constexpr int NCH = RPB / 32;
    struct HgRegs { u32x4 rq, rf, rv; }; HgRegs RG[2];
#define HG_LOAD(n, R) do { const bf16* pr_ = Pb + (size_t)step_row(dir, (n) * 32 + srow) * 512 + c8; R.rq = *(const u32x4*)pr_; R.rv = *(const u32x4*)(pr_ + 128); R.rf = *(const u32x4*)(pr_ + 256 + dir * 128); } while (0)
#define HG_WRITE_RAW(n, R) do { const int o_ = ((n) & 1) * HIMG + srow * RS + c8 * 2; *(LAS u32x4*)(L + H_RAWQ + o_) = R.rq; *(LAS u32x4*)(L + H_RAWF + o_) = R.rf; } while (0)
#define HG_WRITE_V(n, R) do { *(LAS u32x4*)(L + H_V + ((n) & 1) * HIMG + srow * RS + c8 * 2) = R.rv; } while (0)
#define HG_PREP(n) do { const int bi_ = (n) & 1; \
        const bf16x8 af_ = cat8(ds_tr(L + H_RAWF + bi_ * HIMG + (8 * g + q4) * RS + (d0 + 4 * p) * 2), ds_tr(L + H_RAWF + bi_ * HIMG + (8 * g + 4 + q4) * RS + (d0 + 4 * p) * 2)); \
        f32x4 cu_[2]; cu_[0] = MFMA16(af_, LT[0], ((f32x4){0.f, 0.f, 0.f, 0.f})); cu_[1] = MFMA16(af_, LT[1], ((f32x4){0.f, 0.f, 0.f, 0.f})); \
        float cl_[4]; _Pragma("unroll") for (int jj = 0; jj < 4; ++jj) cl_[jj] = lane_get(cu_[1][jj], (lane & 48) | 15); \
        _Pragma("unroll") for (int nt = 0; nt < 2; ++nt) { const int t_ = c + 16 * nt, o_ = t_ * RS + (d0 + 4 * g) * 2, op_ = t_ * RS + (32 * (w >> 1) + 8 * g + 4 * (w & 1)) * 2; \
            const u32x2 qq_ = *(const LAS u32x2*)(L + H_RAWQ + bi_ * HIMG + o_), ff_ = *(const LAS u32x2*)(L + H_RAWF + bi_ * HIMG + o_); \
            const float qv_[4] = {bflo(qq_.x), bfhi(qq_.x), bflo(qq_.y), bfhi(qq_.y)}, lf_[4] = {bflo(ff_.x), bfhi(ff_.x), bflo(ff_.y), bfhi(ff_.y)}; \
            float qt_[4], kb_[4], kt_[4]; \
            _Pragma("unroll") for (int jj = 0; jj < 4; ++jj) { const float cu = cu_[nt][jj], kk = 1.0f - __expf(lf_[jj]); \
                qt_[jj] = qv_[jj] * __expf(cu); kb_[jj] = kk * __expf(fminf(-cu, 80.0f)); kt_[jj] = kk * __expf(cl_[jj] - cu); } \
            u32x2 w_; w_.x = cvtpk(qt_[0], qt_[1]); w_.y = cvtpk(qt_[2], qt_[3]); *(LAS u32x2*)(L + H_QT + bi_ * HIMG + op_) = w_; \
            w_.x = cvtpk(kb_[0], kb_[1]); w_.y = cvtpk(kb_[2], kb_[3]); *(LAS u32x2*)(L + H_KB + bi_ * HIMG + op_) = w_; \
            w_.x = cvtpk(kt_[0], kt_[1]); w_.y = cvtpk(kt_[2], kt_[3]); *(LAS u32x2*)(L + H_KT + bi_ * HIMG + o_) = w_; } \
        if (c == 0) *(LAS f32x4*)(L + H_G + bi_ * 512 + (d0 + 4 * g) * 4) = (f32x4){__expf(cl_[0]), __expf(cl_[1]), __expf(cl_[2]), __expf(cl_[3])}; \
    } while (0)
    static_assert(NCH % 2 == 0, "chunk pairs");
#define HG_STORE_O(m) do { const u32x4 ov_ = *(const LAS u32x4*)(L + H_OST + ((m) & 1) * HIMG + srow * RS + c8 * 2); \
        if (!F.dry) *(u32x4*)(Pb + (size_t)step_row(dir, (m) * 32 + srow) * 512 + 256 + dir * 128 + c8) = ov_; } while (0)
    HG_LOAD(0, RG[0]); HG_LOAD(1, RG[1]); HG_WRITE_RAW(0, RG[0]); HG_WRITE_V(0, RG[0]); HG_LOAD(2, RG[0]);
    __syncthreads();
    HG_PREP(0);
    for (int n2 = 0; n2 < NCH; n2 += 2) {
#pragma unroll
      for (int hh = 0; hh < 2; ++hh) {
        const int n = n2 + hh;
        const int bi = hh;
        if (n + 1 < NCH) HG_WRITE_RAW(n + 1, RG[1 - hh]);
        __syncthreads();
        if (n + 1 < NCH) { HG_WRITE_V(n + 1, RG[1 - hh]); if (n + 3 < NCH) HG_LOAD(n + 3, RG[1 - hh]); }
        if (n > 0) HG_STORE_O(n - 1);
        __builtin_amdgcn_sched_barrier(0);
        if (n + 1 < NCH) HG_PREP(n + 1);
        __builtin_amdgcn_sched_barrier(0);
        {
#define SB() __builtin_amdgcn_sched_barrier(0)
            const LAS unsigned char* Vb = L + H_V + bi * HIMG; const LAS unsigned char* QTb = L + H_QT + bi * HIMG; const LAS unsigned char* KBb = L + H_KB + bi * HIMG; const LAS unsigned char* KTb = L + H_KT + bi * HIMG;
            bf16x8 ka0[4], ka1[4], qb0[4], qb1[4];
#pragma unroll
            for (int ks = 0; ks < 4; ++ks) { const int co = (32 * ks + 8 * g) * 2;
                ka0[ks] = *(const LAS bf16x8*)(KBb + c * RS + co); ka1[ks] = *(const LAS bf16x8*)(KBb + (c + 16) * RS + co);
                qb0[ks] = *(const LAS bf16x8*)(QTb + c * RS + co); qb1[ks] = *(const LAS bf16x8*)(QTb + (c + 16) * RS + co); }
            const bf16x8 bv = cat8(ds_tr(Vb + (4 * g + q4) * RS + (e0 + 4 * p) * 2), ds_tr(Vb + (16 + 4 * g + q4) * RS + (e0 + 4 * p) * 2));
            SB();
            f32x4 at00 = {0.f, 0.f, 0.f, 0.f}, at01 = at00, at11 = at00;
#pragma unroll
            for (int ks = 0; ks < 4; ++ks) { at00 = MFMA16(ka0[ks], qb0[ks], at00); at01 = MFMA16(ka0[ks], qb1[ks], at01); at11 = MFMA16(ka1[ks], qb1[ks], at11); }
            f32x4 o0 = {0.f, 0.f, 0.f, 0.f}, o1 = o0;
#pragma unroll
            for (int ks = 0; ks < 4; ++ks) {
                const bf16x8 Bs = pack8(S[2 * ks][0], S[2 * ks][1], S[2 * ks][2], S[2 * ks][3], S[2 * ks + 1][0], S[2 * ks + 1][1], S[2 * ks + 1][2], S[2 * ks + 1][3]);
                o0 = MFMA16(qb0[ks], Bs, o0); o1 = MFMA16(qb1[ks], Bs, o1);
            }
            SB();
            bf16x8 Ak[8]; f32x4 gv[8];
#pragma unroll
            for (int dt = 0; dt < 8; ++dt) { gv[dt] = *(const LAS f32x4*)(L + H_G + bi * 512 + (16 * dt + 4 * g) * 4);
                Ak[dt] = cat8(ds_tr(KTb + (4 * g + q4) * RS + (16 * dt + 4 * p) * 2), ds_tr(KTb + (16 + 4 * g + q4) * RS + (16 * dt + 4 * p) * 2)); }
            SB();
#pragma unroll
            for (int jj = 0; jj < 4; ++jj) { const bool keep = (4 * g + jj <= c); at00[jj] = keep ? at00[jj] : 0.f; at11[jj] = keep ? at11[jj] : 0.f; }
            const bf16x8 A0 = pack8(at00[0], at00[1], at00[2], at00[3], 0.f, 0.f, 0.f, 0.f), A1 = pack8(at01[0], at01[1], at01[2], at01[3], at11[0], at11[1], at11[2], at11[3]);
            o0 = MFMA16(A0, bv, o0); o1 = MFMA16(A1, bv, o1);
#pragma unroll
            for (int dt = 0; dt < 8; ++dt) S[dt] = MFMA16(Ak[dt], bv, S[dt] * gv[dt]);
            SB();
#pragma unroll
            for (int jj = 0; jj < 4; ++jj) { *(LAS bf16*)(L + H_OST + bi * HIMG + (4 * g + jj) * RS + (e0 + c) * 2) = (bf16)(cvtpk(o0[jj], 0.f) & 0xffffu); *(LAS bf16*)(L + H_OST + bi * HIMG + (16 + 4 * g + jj) * RS + (e0 + c) * 2) = (bf16)(cvtpk(o1[jj], 0.f) & 0xffffu); }
#undef SB
        }
      }
    }
    __syncthreads();
    HG_STORE_O(NCH - 1);
    __syncthreads();
#undef HG_STORE_O
#undef HG_WRITE_V
#undef HG_LOAD
#undef HG_WRITE_RAW
#undef HG_PREP
}


constexpr int D_Q = 0, D_K = 64 * RS, D_V = 2 * 64 * RS, D_NB = 3 * 64 * RS, D_ND = D_NB + 2 * 64 * 144, D_T = D_ND + 2 * 4 * 16 * 17 * 4, D_SC = D_T + 2 * 64 * 48, D_CW = D_SC + 2 * 768, D_DUM = D_CW + 9 * 1536 * 2;
constexpr int NRS = 144, TRS = 48;
static_assert(D_DUM + 256 <= RING_BYTES, "phase D LDS map");
DI void phase_D(Frame& F, int l) {
    make_frame(F);
    LAS unsigned char* L = F.lds;
    const int lane = F.lane, w = F.wave, c = lane & 15, g = lane >> 4;
    const int dir = w >> 2, wq = w & 3;
    const bf16* RAW = F.PREP + PREP_RAW / 2;
    bf16* Wg = F.Wb; bf16* Ug = F.Ub; bf16* QKDg = F.QKDb;
    LAS float* SC = (LAS float*)(L + D_SC + dir * 768);
    LAS float* ND = (LAS float*)(L + D_ND + dir * 4352);
    LAS unsigned char* NBi = L + D_NB + dir * 9216; LAS unsigned char* Ti = L + D_T + dir * 3072;
    { const float* cw = F.dn_conv_w + (size_t)l * 9 * 1536;
      for (int i = F.tid; i < 9 * 1536 / 4; i += 512) { const f32x4 v = ((const f32x4*)cw)[i]; u32x2 o; o.x = cvtpk(v[0], v[1]); o.y = cvtpk(v[2], v[3]); *(LAS u32x2*)(L + D_CW + i * 8) = o; } }
    __syncthreads();
#define D_UNIT(u_) ((F.G == 256) ? (((F.bx & 7) + 8 * ((((u_) >> 8) * 32 + (F.bx >> 3)) / 36)) * 36 + ((((u_) >> 8) * 32 + (F.bx >> 3)) % 36)) : (u_))
    if (F.dry != 2) {
        const int s4 = F.lane >> 4, c8 = (F.lane & 15) * 8;
        const int nun = (NB * 4 * 36 - F.bx + F.G - 1) / F.G;
#define DC_ISSUE(task_, dst, DY0, DY1) do { const int ui_ = (task_) / 12, r12_ = (task_) - 12 * ui_, q_ = r12_ >> 2, t0_ = 16 * (r12_ & 3) + 4 * s4; \
            const int u_ = D_UNIT(F.bx + ui_ * F.G), b_ = u_ / 144, rem_ = u_ - b_ * 144, h_ = rem_ / 36, ck_ = rem_ - h_ * 36; const bool ic_ = ck_ < 4; \
            const char* ub_ = (const char*)(F.PREP + PREP_RAW / 2 + (size_t)b_ * RPB * 1536 + q_ * 512 + h_ * 128); \
            _Pragma("unroll") for (int dy = DY0; dy < DY1; ++dy) _Pragma("unroll") for (int i = 0; i < 6; ++i) { const int xx = t0_ + i - 1, yy = ck_ - 4 + dy - 1; \
                const bool ok = ic_ ? (dy == 1 && 64 * ck_ + xx >= 0 && 64 * ck_ + xx < CTXL) : (yy >= 0 && yy < 32 && xx >= 0 && xx < 64); \
                const unsigned off_ = ok ? (unsigned)((ic_ ? (64 * ck_ + xx) : (CTXL + yy * 64 + xx)) * 1536 + c8) * 2u : (unsigned)c8 * 2u; \
                const u32x4 ld_ = *(const u32x4*)(ub_ + off_); const unsigned m_ = ok ? 0xffffffffu : 0u; dst[dy][i] = (u32x4){ld_.x & m_, ld_.y & m_, ld_.z & m_, ld_.w & m_}; } } while (0)
        u32x4 xv[3][6], xn[2][6];
        if (F.wave < 12 * nun) DC_ISSUE(F.wave, xv, 0, 2);
        for (int task = F.wave; task < 12 * nun; task += 8) {
            const int ui = task / 12, r12 = task - 12 * ui, q = r12 >> 2, t0 = 16 * (r12 & 3) + 4 * s4;
            const int u = D_UNIT(F.bx + ui * F.G), b = u / 144, rem = u - b * 144, h = rem / 36, ck = rem - h * 36;
            DC_ISSUE(task, xv, 2, 3);
            if (task + 8 < 12 * nun) DC_ISSUE(task + 8, xn, 0, 2);
            __builtin_amdgcn_sched_barrier(0);
            float acc[4][8];
#pragma unroll
            for (int o = 0; o < 4; ++o)
#pragma unroll
                for (int j = 0; j < 8; ++j) acc[o][j] = 0.f;
#pragma unroll
            for (int dy = 0; dy < 3; ++dy)
#pragma unroll
                for (int dx = 0; dx < 3; ++dx) { const u32x4 w_ = *(const LAS u32x4*)(L + D_CW + ((dy * 3 + dx) * 1536 + q * 512 + h * 128 + c8) * 2);
                    const float wf[8] = {bflo(w_.x), bfhi(w_.x), bflo(w_.y), bfhi(w_.y), bflo(w_.z), bfhi(w_.z), bflo(w_.w), bfhi(w_.w)};
#pragma unroll
                    for (int o = 0; o < 4; ++o) { const u32x4 x = xv[dy][o + dx];
                        acc[o][0] += bflo(x.x) * wf[0]; acc[o][1] += bfhi(x.x) * wf[1]; acc[o][2] += bflo(x.y) * wf[2]; acc[o][3] += bfhi(x.y) * wf[3];
                        acc[o][4] += bflo(x.z) * wf[4]; acc[o][5] += bfhi(x.z) * wf[5]; acc[o][6] += bflo(x.w) * wf[6]; acc[o][7] += bfhi(x.w) * wf[7]; } }
#pragma unroll
            for (int o = 0; o < 4; ++o) {
                float ss = 0.f;
#pragma unroll
                for (int j = 0; j < 8; ++j) { acc[o][j] = silu_f(acc[o][j]); ss += acc[o][j] * acc[o][j]; }
                if (q < 2) { ss += swz<1>(ss); ss += swz<2>(ss); ss += swz<4>(ss); ss += swz<8>(ss);
                    const float sc = __builtin_amdgcn_rsqf(ss + EPS) * (q == 0 ? 0.08838834764831845f : 1.0f);
#pragma unroll
                    for (int j = 0; j < 8; ++j) acc[o][j] *= sc; }
                u32x4 ov; ov.x = cvtpk(acc[o][0], acc[o][1]); ov.y = cvtpk(acc[o][2], acc[o][3]); ov.z = cvtpk(acc[o][4], acc[o][5]); ov.w = cvtpk(acc[o][6], acc[o][7]);
                *(u32x4*)(F.QKN + qkn_idx(b, h, 64 * ck + t0 + o) + q * 128 + c8) = ov;
            }
#pragma unroll
            for (int dy = 0; dy < 2; ++dy)
#pragma unroll
                for (int i = 0; i < 6; ++i) xv[dy][i] = xn[dy][i];
        }
#undef DC_ISSUE
    }
    asm volatile("s_waitcnt vmcnt(0)" ::: "memory");
    __syncthreads();
    const int irow = F.tid >> 3, c16 = (F.tid & 7) * 16;
    u32x4 im[6]; float pla = 0.f, pbe = 0.f;
#define D_ISSUE(u_) do { const int b_ = (u_) / 144, rem_ = (u_) - b_ * 144, h_ = rem_ / 36, ck_ = rem_ - h_ * 36; \
        const bf16* src_ = F.QKN + qkn_idx(b_, h_, 64 * ck_ + irow) + c16; \
        _Pragma("unroll") for (int q = 0; q < 3; ++q) { im[2 * q] = *(const u32x4*)(src_ + 128 * q); im[2 * q + 1] = *(const u32x4*)(src_ + 128 * q + 8); } \
        if (wq == 0) { int ln_ = lane; asm volatile("" : "+v"(ln_)); const int tk_ = dir ? 63 - ln_ : ln_; const size_t tr_ = (size_t)b_ * RPB + 64 * ck_ + tk_; pla = F.LOGA[((size_t)dir * T + tr_) * 4 + h_]; pbe = F.BETA[((size_t)dir * T + tr_) * 4 + h_]; } } while (0)
    const int uend = F.dry == 1 ? 0 : NB * 4 * 36;
    if (F.bx < uend) D_ISSUE(D_UNIT(F.bx));
    for (int uu = F.bx; uu < uend; uu += F.G) {
        const int u = D_UNIT(uu);
        const int b = u / 144, rem = u - b * 144, h = rem / 36, ck = rem - h * 36;
        const int n = dir == 0 ? ck : (ck < 4 ? 3 - ck : 39 - ck);
        const size_t srow0 = (size_t)b * RPB + 64 * n;
#pragma unroll
        for (int q = 0; q < 3; ++q) { *(LAS u32x4*)(L + q * 64 * RS + irow * RS + c16 * 2) = im[2 * q]; *(LAS u32x4*)(L + q * 64 * RS + irow * RS + c16 * 2 + 16) = im[2 * q + 1]; }
        if (wq == 0) {
            int ln_o = F.lane; asm volatile("" : "+v"(ln_o)); const int lane = ln_o;
            float cu = pla;
#pragma unroll
            for (int o = 1; o < 64; o <<= 1) { const float t_ = lane_get(cu, (lane - o) & 63); if (lane >= o) cu += t_; }
            SC[lane] = cu; SC[64 + lane] = pbe; SC[128 + lane] = pbe * __expf(cu);
            F.CUM[((size_t)dir * T + srow0 + lane) * 4 + h] = cu;
        }
        __syncthreads();
        if (uu + F.G < NB * 4 * 36) D_ISSUE(D_UNIT(uu + F.G));
        {
            int c_o = lane & 15, g_o = lane >> 4; asm volatile("" : "+v"(c_o), "+v"(g_o)); const int c = c_o, g = g_o;
            bf16* qkd = QKDg + ((size_t)((dir * 64 + b * 4 + h) * 36 + n)) * 4096;
            const int it = wq;
            f32x4 kk[4], qk[4];
#pragma unroll
            for (int jt = 0; jt < 4; ++jt) { kk[jt] = (f32x4){0.f, 0.f, 0.f, 0.f}; qk[jt] = kk[jt]; }
#pragma unroll
            for (int ks = 0; ks < 4; ++ks) { const int co = (32 * ks + 8 * g) * 2;
                const bf16x8 ak = *(const LAS bf16x8*)(L + D_K + (16 * it + c) * RS + co), aq = *(const LAS bf16x8*)(L + D_Q + (16 * it + c) * RS + co);
#pragma unroll
                for (int jt = 0; jt < 4; ++jt) { const bf16x8 bk = *(const LAS bf16x8*)(L + D_K + (4 * c + jt) * RS + co); kk[jt] = MFMA16(ak, bk, kk[jt]); qk[jt] = MFMA16(aq, bk, qk[jt]); } }
#pragma unroll
            for (int jj = 0; jj < 4; ++jj) { const int toki = 16 * it + 4 * g + jj, i = dir ? 63 - toki : toki; const float ci = SC[i], be_i = SC[64 + i];
                float nb4[4], qk4[4];
#pragma unroll
                for (int jt = 0; jt < 4; ++jt) { const int tokj = 4 * c + jt, ip = dir ? 63 - tokj : tokj;
                    const float dec = __expf(fminf(ci - SC[ip], 0.f));
                    const float nv = (i > ip) ? be_i * kk[jt][jj] * dec : 0.f;
                    const bool same = (i >> 4) == (ip >> 4);
                    *(same ? &ND[((i >> 4) * 16 + (i & 15)) * 17 + (ip & 15)] : (LAS float*)(L + D_DUM) + (lane & 63)) = nv;
                    nb4[jt] = same ? 0.f : -nv;
                    qk4[jt] = (i >= ip) ? qk[jt][jj] * dec : 0.f; }
                u32x2 nbw, qkw;
                if (dir == 0) { nbw.x = cvtpk(nb4[0], nb4[1]); nbw.y = cvtpk(nb4[2], nb4[3]); qkw.x = cvtpk(qk4[0], qk4[1]); qkw.y = cvtpk(qk4[2], qk4[3]); }
                else { nbw.x = cvtpk(nb4[3], nb4[2]); nbw.y = cvtpk(nb4[1], nb4[0]); qkw.x = cvtpk(qk4[3], qk4[2]); qkw.y = cvtpk(qk4[1], qk4[0]); }
                const int col0 = dir ? 60 - 4 * c : 4 * c;
                *(LAS u32x2*)(NBi + i * NRS + col0 * 2) = nbw;
                *(u32x2*)(qkd + i * 64 + col0) = qkw; }
        }
        __syncthreads();
        if (wq == 0) {
            int c_o = lane & 15, g_o = lane >> 4; asm volatile("" : "+v"(c_o), "+v"(g_o)); const int c = c_o, g = g_o;
            float Tc[16];
#pragma unroll
            for (int r = 0; r < 16; ++r) { float a = (r == c) ? 1.f : 0.f;
#pragma unroll
                for (int s2 = 0; s2 < r; ++s2) a -= ND[(g * 16 + r) * 17 + s2] * Tc[s2];
                Tc[r] = a; }
#pragma unroll
            for (int r = 0; r < 16; ++r) *(LAS bf16*)(Ti + (16 * g + r) * TRS + c * 2) = (bf16)(cvtpk(Tc[r], 0.f) & 0xffffu);
        }
        __syncthreads();
        {
            int c_o = lane & 15, g_o = lane >> 4; asm volatile("" : "+v"(c_o), "+v"(g_o)); const int c = c_o, g = g_o;
            const bool isw = wq < 2; const int srcimg = isw ? D_K : D_V, cb = (wq & 1) * 64; const LAS float* scl = SC + (isw ? 128 : 64);
            bf16* og = (isw ? Wg : Ug) + wu_idx(dir, b, h, 64 * n) + cb + 4 * c;
            u32x2 sv[4][4]; float scv[4][4]; bf16x8 An[4], ATv[4];
#pragma unroll
            for (int i = 0; i < 4; ++i)
#pragma unroll
                for (int jj = 0; jj < 4; ++jj) { const int row = 16 * i + 4 * g + jj, tok = dir ? 63 - row : row; scv[i][jj] = scl[row];
                    sv[i][jj] = *(const LAS u32x2*)(L + srcimg + tok * RS + (cb + 4 * c) * 2); }
#define D_NFRAG(i_, ks_) cat8(*(const LAS s16x4*)(NBi + (16 * (i_) + c) * NRS + (32 * (ks_) + 4 * g) * 2), *(const LAS s16x4*)(NBi + (16 * (i_) + c) * NRS + (32 * (ks_) + 16 + 4 * g) * 2))
            An[0] = D_NFRAG(1, 0); An[1] = D_NFRAG(2, 0); An[2] = D_NFRAG(3, 0); An[3] = D_NFRAG(3, 1);
#undef D_NFRAG
            { const s16x4 z4 = {0, 0, 0, 0};
#pragma unroll
              for (int i = 0; i < 4; ++i) ATv[i] = cat8(*(const LAS s16x4*)(Ti + (16 * i + c) * TRS + 4 * g * 2), z4); }
            __builtin_amdgcn_sched_barrier(0);
            f32x4 Xt[4][4];
#pragma unroll
            for (int i = 0; i < 4; ++i) {
                f32x4 acc[4];
#pragma unroll
                for (int jj = 0; jj < 4; ++jj) { const float sc_ = scv[i][jj]; const u32x2 sv_ = sv[i][jj];
                    acc[0][jj] = bflo(sv_.x) * sc_; acc[1][jj] = bfhi(sv_.x) * sc_; acc[2][jj] = bflo(sv_.y) * sc_; acc[3][jj] = bfhi(sv_.y) * sc_; }
                if (i >= 1) {
#pragma unroll
                    for (int nt = 0; nt < 4; ++nt) { const bool two = i >= 2;
                        const bf16x8 B = pack8(Xt[0][nt][0], Xt[0][nt][1], Xt[0][nt][2], Xt[0][nt][3], two ? Xt[1][nt][0] : 0.f, two ? Xt[1][nt][1] : 0.f, two ? Xt[1][nt][2] : 0.f, two ? Xt[1][nt][3] : 0.f);
                        acc[nt] = MFMA16(An[i - 1], B, acc[nt]); } }
                if (i == 3) {
#pragma unroll
                    for (int nt = 0; nt < 4; ++nt) { const bf16x8 B = pack8(Xt[2][nt][0], Xt[2][nt][1], Xt[2][nt][2], Xt[2][nt][3], 0.f, 0.f, 0.f, 0.f);
                        acc[nt] = MFMA16(An[3], B, acc[nt]); } }
#pragma unroll
                for (int nt = 0; nt < 4; ++nt) { const bf16x8 BY = pack8(acc[nt][0], acc[nt][1], acc[nt][2], acc[nt][3], 0.f, 0.f, 0.f, 0.f);
                    Xt[i][nt] = MFMA16(ATv[i], BY, ((f32x4){0.f, 0.f, 0.f, 0.f})); }
#pragma unroll
                for (int jj = 0; jj < 4; ++jj) { u32x2 ov_; ov_.x = cvtpk(Xt[i][0][jj], Xt[i][1][jj]); ov_.y = cvtpk(Xt[i][2][jj], Xt[i][3][jj]);
                    *(u32x2*)(og + (16 * i + 4 * g + jj) * 128) = ov_; }
            }
        }
        __syncthreads();
    }
#undef D_ISSUE
#undef D_UNIT
}

constexpr int E_W = 0, E_U = 64 * RS, E_QD = 2 * 64 * RS, E_KD = 3 * 64 * RS, E_QK = 4 * 64 * RS, E_OST = E_QK + 64 * NRS, E_GT = E_OST + 64 * RS;
DI void dn_unit(Frame& F, int unit) {
    make_frame(F);
    const int b = unit >> 3, h = (unit >> 1) & 3, dir = unit & 1;
    LAS unsigned char* L = F.lds;
    const int lane = F.lane, w = F.wave, c = lane & 15, g = lane >> 4, q4 = (lane & 15) >> 2, p = lane & 3;
    const int e0 = 16 * w;
    const int row = F.tid >> 3, c16 = (F.tid & 7) * 16;
    const bf16* QKN = F.QKN;
    const bf16* Wg = F.Wb + wu_idx(dir, b, h, 0);
    bf16* Ug = F.Ub + wu_idx(dir, b, h, 0);
    const bf16* QKDg = F.QKDb + (size_t)((dir * 64 + b * 4 + h) * 36) * 4096;
    const float* CUMg = F.CUM + ((size_t)dir * T + (size_t)b * RPB) * 4 + h;
    f32x4 S[8];
#pragma unroll
    for (int dt = 0; dt < 8; ++dt) S[dt] = (f32x4){0.f, 0.f, 0.f, 0.f};
    constexpr int NCH = RPB / 64;
    struct DnRegs { u32x4 rw0, rw1, ru0, ru1, rq0, rq1, rk0, rk1, rqk; float rcu, rcl; };
    DnRegs RG[2];
    const unsigned wu_off = (unsigned)(row * 128 + c16) * 2u, q_off = (unsigned)((dir == 0 ? row : 63 - row) * 384 + c16) * 2u, qk_off = (unsigned)F.tid * 16u, cu_off = (unsigned)row * 16u;
#define DN_LOAD(n, R) do { const int br_ = dir == 0 ? (n) * 64 : ((n) < CTXL / 64 ? CTXL - 64 - (n) * 64 : RPB + CTXL - 64 - (n) * 64); \
        const char* pw_ = (const char*)(Wg + (size_t)(n) * 64 * 128); const char* pu_ = (const char*)(Ug + (size_t)(n) * 64 * 128); \
        const char* pq_ = (const char*)(QKN + qkn_idx(b, h, br_)); const char* pc_ = (const char*)(CUMg + (size_t)(n) * 64 * 4); \
        R.rw0 = *(const u32x4*)(pw_ + wu_off); R.rw1 = *(const u32x4*)(pw_ + wu_off + 16); R.ru0 = *(const u32x4*)(pu_ + wu_off); R.ru1 = *(const u32x4*)(pu_ + wu_off + 16); \
        R.rq0 = *(const u32x4*)(pq_ + q_off); R.rq1 = *(const u32x4*)(pq_ + q_off + 16); R.rk0 = *(const u32x4*)(pq_ + q_off + 256); R.rk1 = *(const u32x4*)(pq_ + q_off + 272); \
        R.rqk = *(const u32x4*)((const char*)(QKDg + (size_t)(n) * 4096) + qk_off); R.rcu = *(const float*)(pc_ + cu_off); R.rcl = *(const float*)(pc_ + 63 * 16); } while (0)
#define DN_SCALE8(dst, src, f) do { dst.x = cvtpk(bflo(src.x) * (f), bfhi(src.x) * (f)); dst.y = cvtpk(bflo(src.y) * (f), bfhi(src.y) * (f)); dst.z = cvtpk(bflo(src.z) * (f), bfhi(src.z) * (f)); dst.w = cvtpk(bflo(src.w) * (f), bfhi(src.w) * (f)); } while (0)
#define DN_WRITE(R) do { const int o_ = row * RS + c16 * 2, op_ = row * RS + (32 * (c16 >> 5) + 4 * ((c16 >> 4) & 1)) * 2; \
        *(LAS u32x2*)(L + E_W + op_) = (u32x2){R.rw0.x, R.rw0.y}; *(LAS u32x2*)(L + E_W + op_ + 16) = (u32x2){R.rw0.z, R.rw0.w}; *(LAS u32x2*)(L + E_W + op_ + 32) = (u32x2){R.rw1.x, R.rw1.y}; *(LAS u32x2*)(L + E_W + op_ + 48) = (u32x2){R.rw1.z, R.rw1.w}; \
        *(LAS u32x4*)(L + E_U + o_) = R.ru0; *(LAS u32x4*)(L + E_U + o_ + 16) = R.ru1; \
        const float fq_ = __expf(R.rcu), fk_ = __expf(R.rcl - R.rcu); u32x4 t_; \
        DN_SCALE8(t_, R.rq0, fq_); *(LAS u32x2*)(L + E_QD + op_) = (u32x2){t_.x, t_.y}; *(LAS u32x2*)(L + E_QD + op_ + 16) = (u32x2){t_.z, t_.w}; \
        DN_SCALE8(t_, R.rq1, fq_); *(LAS u32x2*)(L + E_QD + op_ + 32) = (u32x2){t_.x, t_.y}; *(LAS u32x2*)(L + E_QD + op_ + 48) = (u32x2){t_.z, t_.w}; \
        DN_SCALE8(t_, R.rk0, fk_); *(LAS u32x4*)(L + E_KD + o_) = t_; DN_SCALE8(t_, R.rk1, fk_); *(LAS u32x4*)(L + E_KD + o_ + 16) = t_; \
        *(LAS u32x4*)(L + E_QK + (F.tid >> 3) * NRS + (F.tid & 7) * 16) = R.rqk; \
        if (F.tid == 0) *(LAS float*)(L + E_GT) = __expf(R.rcl); } while (0)
    DN_LOAD(0, RG[0]); DN_LOAD(1, RG[1]);
    for (int n2 = 0; n2 < NCH; n2 += 2) {
#pragma unroll
      for (int hh = 0; hh < 2; ++hh) {
        const int n = n2 + hh;
        DN_WRITE(RG[hh]);
        __syncthreads();
        if (n + 2 < NCH) DN_LOAD(n + 2, RG[hh]);
        __builtin_amdgcn_sched_barrier(0);
        {
#define SB() __builtin_amdgcn_sched_barrier(0)
#define DN_LDWQ(fw, fq, ks, mh) do { _Pragma("unroll") for (int m2 = 0; m2 < 2; ++m2) { const int ro_ = (16 * (2 * (mh) + m2) + c) * RS + (32 * (ks) + 8 * g) * 2; \
                fw[m2] = *(const LAS bf16x8*)(L + E_W + ro_); fq[m2] = *(const LAS bf16x8*)(L + E_QD + ro_); } } while (0)
#define DN_PACKS(ks) do { \
            Bs_ = pack8(S[2 * (ks)][0], S[2 * (ks)][1], S[2 * (ks)][2], S[2 * (ks)][3], S[2 * (ks) + 1][0], S[2 * (ks) + 1][1], S[2 * (ks) + 1][2], S[2 * (ks) + 1][3]); \
            Bn_ = pack8(-S[2 * (ks)][0], -S[2 * (ks)][1], -S[2 * (ks)][2], -S[2 * (ks)][3], -S[2 * (ks) + 1][0], -S[2 * (ks) + 1][1], -S[2 * (ks) + 1][2], -S[2 * (ks) + 1][3]); } while (0)
#define DN_MMWQ(fw, fq, mh) do { _Pragma("unroll") for (int m2 = 0; m2 < 2; ++m2) { vn[2 * (mh) + m2] = MFMA16(fw[m2], Bn_, vn[2 * (mh) + m2]); oo[2 * (mh) + m2] = MFMA16(fq[m2], Bs_, oo[2 * (mh) + m2]); } } while (0)
#define DN_LDK(fk, dt0) do { _Pragma("unroll") for (int d_ = 0; d_ < 4; ++d_) _Pragma("unroll") for (int ks = 0; ks < 2; ++ks) \
                fk[d_][ks] = cat8(ds_tr(L + E_KD + (32 * ks + 4 * g + q4) * RS + (16 * ((dt0) + d_) + 4 * p) * 2), ds_tr(L + E_KD + (32 * ks + 16 + 4 * g + q4) * RS + (16 * ((dt0) + d_) + 4 * p) * 2)); } while (0)
#define DN_MMK(fk, dt0) do { _Pragma("unroll") for (int d_ = 0; d_ < 4; ++d_) { f32x4 sv_ = S[(dt0) + d_] * gt; sv_ = MFMA16(fk[d_][0], Bv[0], sv_); sv_ = MFMA16(fk[d_][1], Bv[1], sv_); S[(dt0) + d_] = sv_; } } while (0)
            f32x4 vn[4], oo[4];
            bf16x8 f0w[2], f0q[2], f1w[2], f1q[2], Bs_, Bn_;
            DN_LDWQ(f0w, f0q, 0, 0);
#pragma unroll
            for (int mt = 0; mt < 4; ++mt)
#pragma unroll
                for (int jj = 0; jj < 4; ++jj) vn[mt][jj] = bf2f(*(const LAS bf16*)(L + E_U + (16 * mt + 4 * g + jj) * RS + (e0 + c) * 2));
#pragma unroll
            for (int mt = 0; mt < 4; ++mt) oo[mt] = (f32x4){0.f, 0.f, 0.f, 0.f};
            const float gt = *(const LAS float*)(L + E_GT);
            SB(); DN_LDWQ(f1w, f1q, 0, 1); DN_PACKS(0); SB(); DN_MMWQ(f0w, f0q, 0); SB();
            DN_LDWQ(f0w, f0q, 1, 0); SB(); DN_MMWQ(f1w, f1q, 1); SB();
            DN_LDWQ(f1w, f1q, 1, 1); DN_PACKS(1); SB(); DN_MMWQ(f0w, f0q, 0); SB();
            DN_LDWQ(f0w, f0q, 2, 0); SB(); DN_MMWQ(f1w, f1q, 1); SB();
            DN_LDWQ(f1w, f1q, 2, 1); DN_PACKS(2); SB(); DN_MMWQ(f0w, f0q, 0); SB();
            DN_LDWQ(f0w, f0q, 3, 0); SB(); DN_MMWQ(f1w, f1q, 1); SB();
            DN_LDWQ(f1w, f1q, 3, 1); DN_PACKS(3); SB(); DN_MMWQ(f0w, f0q, 0); SB();
            DN_MMWQ(f1w, f1q, 1); SB();
            bf16x8 fa[2][4];
#pragma unroll
            for (int ks = 0; ks < 2; ++ks)
#pragma unroll
                for (int mt = 0; mt < 4; ++mt) { const int ro = (16 * mt + c) * NRS + (32 * ks + 4 * g) * 2; fa[ks][mt] = cat8(*(const LAS s16x4*)(L + E_QK + ro), *(const LAS s16x4*)(L + E_QK + ro + 32)); }
            bf16x8 k0[4][2];
            DN_LDK(k0, 0); SB();
            bf16x8 Bv[2];
#pragma unroll
            for (int ks = 0; ks < 2; ++ks) Bv[ks] = pack8(vn[2 * ks][0], vn[2 * ks][1], vn[2 * ks][2], vn[2 * ks][3], vn[2 * ks + 1][0], vn[2 * ks + 1][1], vn[2 * ks + 1][2], vn[2 * ks + 1][3]);
#pragma unroll
            for (int ks = 0; ks < 2; ++ks)
#pragma unroll
                for (int mt = 0; mt < 4; ++mt) oo[mt] = MFMA16(fa[ks][mt], Bv[ks], oo[mt]);
            SB(); DN_MMK(k0, 0); SB(); DN_LDK(k0, 4); SB();
#pragma unroll
            for (int mt = 0; mt < 4; ++mt)
#pragma unroll
                for (int jj = 0; jj < 4; ++jj) *(LAS bf16*)(L + E_OST + (16 * mt + 4 * g + jj) * RS + (e0 + c) * 2) = (bf16)(cvtpk(oo[mt][jj], 0.f) & 0xffffu);
            DN_MMK(k0, 4);
#undef DN_LDWQ
#undef DN_MMWQ
#undef DN_PACKS
#undef DN_LDK
#undef DN_MMK
#undef SB
        }
        __syncthreads();
        {
            const u32x4 o0 = *(const LAS u32x4*)(L + E_OST + row * RS + c16 * 2), o1 = *(const LAS u32x4*)(L + E_OST + row * RS + c16 * 2 + 16);
            bf16* po = Ug + ((size_t)n * 64 + row) * 128 + c16;
            if (!F.dry) { *(u32x4*)po = o0; *(u32x4*)(po + 8) = o1; }
        }
      }
    }
    __syncthreads();
#undef DN_LOAD
#undef DN_SCALE8
#undef DN_WRITE
}

DI void phase_E_naive(Frame& F) {
    for (int u = F.bx; u < 256; u += F.G) { if (u < 128) { if (F.dry != 2) hg_unit(F, u); } else { if (F.dry != 1) dn_unit(F, u - 128); } }
}

DI void phase_F(Frame& F, int l) {
    make_frame(F);
    const int gw = F.bx * 8 + F.wave, NGW = F.G * 8;
    const bf16* U = F.Ub; bf16* MIX = F.HBQ;
    const int grp = F.lane >> 5, cg = (F.lane & 31) * 16;
    const float* nw = (grp == 0 ? F.hg_norm_w : F.dn_norm_w) + l * HD + (cg & 127);
    float nwv[16];
#pragma unroll
    for (int j = 0; j < 16; ++j) nwv[j] = nw[j];
    for (int t = gw; t < T; t += NGW) {
        const bf16 *pf, *pb, *pg;
        const int bb = t / RPB, rr = t - bb * RPB, hh = cg >> 7, dd = cg & 127;
        if (grp == 0) { const bf16* p = F.PHG + phg_idx(bb, hh, rr) + dd; pf = p + 256; pb = p + 384; pg = F.PHG + PHG_G + (size_t)t * 512 + cg; }
        else { pf = U + wu_idx(0, bb, hh, rr) + dd; pb = U + wu_idx(1, bb, hh, step_row(1, rr)) + dd; pg = F.PZ + (size_t)t * 512 + cg; }
        float o[16], g[16]; float ss = 0.f;
#pragma unroll
        for (int q = 0; q < 2; ++q) { const u32x4 a = *(const u32x4*)(pf + 8 * q), c = *(const u32x4*)(pb + 8 * q), gg = *(const u32x4*)(pg + 8 * q);
            const unsigned aa[4] = {a.x, a.y, a.z, a.w}, ca[4] = {c.x, c.y, c.z, c.w}, ga[4] = {gg.x, gg.y, gg.z, gg.w};
#pragma unroll
            for (int j = 0; j < 4; ++j) { o[8 * q + 2 * j] = bflo(aa[j]) + bflo(ca[j]); o[8 * q + 2 * j + 1] = bfhi(aa[j]) + bfhi(ca[j]); g[8 * q + 2 * j] = bflo(ga[j]); g[8 * q + 2 * j + 1] = bfhi(ga[j]); } }
#pragma unroll
        for (int j = 0; j < 16; ++j) ss += o[j] * o[j];
        ss += swz<1>(ss); ss += swz<2>(ss); ss += swz<4>(ss);
        const float rstd = __builtin_amdgcn_rsqf(ss * (1.0f / HD) + EPS);
        unsigned w[8];
#pragma unroll
        for (int j = 0; j < 8; ++j) w[j] = cvt_pk_bf16(o[2 * j] * rstd * nwv[2 * j] * silu_f(g[2 * j]), o[2 * j + 1] * rstd * nwv[2 * j + 1] * silu_f(g[2 * j + 1]));
        u32x4* mo = (u32x4*)(MIX + (size_t)t * D + F.lane * 16);
        mo[0] = (u32x4){w[0], w[1], w[2], w[3]}; mo[1] = (u32x4){w[4], w[5], w[6], w[7]};
    }
}

DI void expert_weight_transposes(Frame& F, int l, int rank, int nblk, int part) {
    LAS float* scr = (LAS float*)(F.lds + F.wave * 8448);
    bf16* WGU = (bf16*)((char*)F.out + XO_WGU); bf16* WDN = (bf16*)((char*)F.out + XO_WDN);
    constexpr int I_G = 16 * 16, I_D = 8 * 32;
    if (part == 0) {
        auto dec = [&](int it) -> TrItem { const int e = it / (2 * I_G); int r = it - e * (2 * I_G); const int up = r >= I_G; if (up) r -= I_G; const int kb = r >> 4, nb = r & 15, n0 = 32 * nb;
            return TrItem{(up ? F.w_up : F.w_gate) + ((size_t)l * NE + e) * D * FF, WGU + (size_t)e * D * D, FF, D, 64 * kb, n0, 256 * (n0 >> 7) + (n0 & 127) + (up ? 128 : 0)}; };
        TRANSPOSE_LOOP(rank * 8 + F.wave, NE * 2 * I_G, nblk * 8, dec);
    } else {
        auto dec = [&](int it) -> TrItem { const int e = it / I_D, r = it - e * I_D; const int kb = r >> 5, nb = r & 31;
            return TrItem{F.w_down + ((size_t)l * NE + e) * FF * D, WDN + (size_t)e * D * FF, D, FF, 64 * kb, 32 * nb, 32 * nb}; };
        TRANSPOSE_LOOP(rank * 8 + F.wave, NE * I_D, nblk * 8, dec);
    }
}

constexpr int HW_WT = 0, HW_WSC = 40 * HW_WTS, HW_SH = HW_WSC + 2 * 1024 * 4, HW_LG = HW_SH + 2 * 1024 * 4, HW_RS = HW_LG + 8 * 16 * 25 * 4, HW_RS2 = HW_RS + 8 * 16 * 4, HW_RT = HW_RS2 + 16 * 4;
DI void phase_H(Frame& F, int l) {
    make_frame(F);
    const bool lastl = (l == DEPTH - 1);
    LAS unsigned char* L = F.lds;
    const int lane = F.lane, w = F.wave, c = lane & 15, g = lane >> 4;
    LAS int* rtE = (LAS int*)(L + HW_RT);
    LAS float* rtW = (LAS float*)(rtE + 288);
    LAS int* lcnt = (LAS int*)(rtW + 288);
    LAS int* lbase = lcnt + 16;
    LAS int* lpos = lbase + 16;
    for (int k = F.tid; k < D; k += 512) {
        const f32x4* we = (const f32x4*)(F.w_expert + ((size_t)l * D + k) * 16); const f32x4 wg = *(const f32x4*)(F.w_group + ((size_t)l * D + k) * 4);
#pragma unroll
        for (int q4 = 0; q4 < 4; ++q4) { const f32x4 e4 = we[q4];
#pragma unroll
            for (int j = 0; j < 4; ++j) { const unsigned hi = cvtpk(e4[j], 0.f) & 0xffffu; const unsigned lo = cvtpk(e4[j] - __uint_as_float(hi << 16), 0.f) & 0xffffu;
                *(LAS bf16*)(L + HW_WT + (4 * q4 + j) * HW_WTS + k * 2) = (bf16)hi; *(LAS bf16*)(L + HW_WT + (16 + 4 * q4 + j) * HW_WTS + k * 2) = (bf16)lo; } }
#pragma unroll
        for (int j = 0; j < 4; ++j) { const unsigned hi = cvtpk(wg[j], 0.f) & 0xffffu; const unsigned lo = cvtpk(wg[j] - __uint_as_float(hi << 16), 0.f) & 0xffffu;
            *(LAS bf16*)(L + HW_WT + (32 + j) * HW_WTS + k * 2) = (bf16)hi; *(LAS bf16*)(L + HW_WT + (36 + j) * HW_WTS + k * 2) = (bf16)lo; }
    }
    const float* n2 = F.norm2_w + l * D;
    unsigned* CNT = (unsigned*)(F.ctl + CW_CNT + (l + (F.dry ? DEPTH : 0)) * 16 * 64);
    const int RPU = lastl ? 128 : 144, RPW = RPU / 8, NU = lastl ? NB * (SEQ / 128) : T / 144;
    for (int u = F.bx; u < NU; u += F.G) {
        const int t0 = lastl ? (u >> 4) * RPB + CTXL + (u & 15) * 128 : u * 144;
        const int bblk = t0 / RPB;
        int tid0 = F.tid; asm volatile("" : "+v"(tid0));
        if (tid0 < 16) lcnt[tid0] = 0;
        for (int i = tid0; i < 2 * D; i += 512) { const int cls = i >> 10, k = i & 1023; const float* md = F.MOD + ((size_t)l * 17 + (cls ? 16 : bblk)) * MODW + 3 * D;
            *(LAS float*)(L + HW_WSC + i * 4) = n2[k] * (md[D + k] + 1.0f); *(LAS float*)(L + HW_SH + i * 4) = md[k]; }
        __syncthreads();
#define H_LD(dst, k0, NQ) do { _Pragma("unroll") for (int q_ = 0; q_ < (NQ); ++q_) dst[q_] = *(const u32x4*)(xrow + 32 * ((k0) + q_)); } while (0)
#define H_LOGITS(src, k0, NQ) do { _Pragma("unroll") for (int q_ = 0; q_ < (NQ); ++q_) { const int ks = (k0) + q_; \
                const u32x4 x = src[q_]; const f32x4 w0 = *(const LAS f32x4*)(wscp + ks * 128), w1 = *(const LAS f32x4*)(wscp + ks * 128 + 16); \
                const float x0 = bflo(x.x), x1 = bfhi(x.x), x2 = bflo(x.y), x3 = bfhi(x.y), x4 = bflo(x.z), x5 = bfhi(x.z), x6 = bflo(x.w), x7 = bfhi(x.w); \
                ss8[0] += x0 * x0; ss8[1] += x1 * x1; ss8[2] += x2 * x2; ss8[3] += x3 * x3; ss8[4] += x4 * x4; ss8[5] += x5 * x5; ss8[6] += x6 * x6; ss8[7] += x7 * x7; \
                const float h0 = x0 * w0[0], h1 = x1 * w0[1], h2 = x2 * w0[2], h3 = x3 * w0[3], h4 = x4 * w1[0], h5 = x5 * w1[1], h6 = x6 * w1[2], h7 = x7 * w1[3]; \
                u32x4 ah; ah.x = cvtpk(h0, h1); ah.y = cvtpk(h2, h3); ah.z = cvtpk(h4, h5); ah.w = cvtpk(h6, h7); \
                const bf16x8 Ah = __builtin_bit_cast(bf16x8, ah); \
                const bf16x8 Al = pack8(h0 - bflo(ah.x), h1 - bfhi(ah.x), h2 - bflo(ah.y), h3 - bfhi(ah.y), h4 - bflo(ah.z), h5 - bfhi(ah.z), h6 - bflo(ah.w), h7 - bfhi(ah.w)); \
                const bf16x8 B0 = *(const LAS bf16x8*)(b0p + ks * 64), B1 = *(const LAS bf16x8*)(b1p + ks * 64), B2 = *(const LAS bf16x8*)(b2p + ks * 64); \
                acc0 = MFMA16(Ah, B0, acc0); acc0 = MFMA16(Al, B0, acc0); acc0 = MFMA16(Ah, B1, acc0); acc1 = MFMA16(Ah, B2, acc1); acc1 = MFMA16(Al, B2, acc1); } } while (0)
#define H_OUT(src, k0, NQ) do { _Pragma("unroll") for (int q_ = 0; q_ < (NQ); ++q_) { const int ks = (k0) + q_; \
                const u32x4 x = src[q_]; const f32x4 w0 = *(const LAS f32x4*)(wscp + ks * 128), w1 = *(const LAS f32x4*)(wscp + ks * 128 + 16), s0 = *(const LAS f32x4*)(shp + ks * 128), s1 = *(const LAS f32x4*)(shp + ks * 128 + 16); \
                u32x4 o; o.x = cvtpk(bflo(x.x) * w0[0] * rstd + s0[0], bfhi(x.x) * w0[1] * rstd + s0[1]); o.y = cvtpk(bflo(x.y) * w0[2] * rstd + s0[2], bfhi(x.y) * w0[3] * rstd + s0[3]); \
                o.z = cvtpk(bflo(x.z) * w1[0] * rstd + s1[0], bfhi(x.z) * w1[1] * rstd + s1[1]); o.w = cvtpk(bflo(x.w) * w1[2] * rstd + s1[2], bfhi(x.w) * w1[3] * rstd + s1[3]); \
                *(u32x4*)(ho + 32 * ks) = o; } } while (0)
#define H_ROUTE(LG_, RS_, rowi, rl2) do { const int t2 = t0 + (rl2); const int rr2 = t2 - (t2 / RPB) * RPB, mod2 = rr2 < CTXL ? 16 : bblk; \
                const float* ch = F.CH + (l * 17 + mod2) * 20;        \
                const float rs = RS_[rowi]; \
                float gl[4], ex[16]; \
                _Pragma("unroll") for (int q = 0; q < 16; ++q) ex[q] = LG_[(rowi) * 25 + q] * rs + ch[4 + q]; \
                _Pragma("unroll") for (int q = 0; q < 4; ++q) gl[q] = (LG_[(rowi) * 25 + 16 + q] + LG_[(rowi) * 25 + 20 + q]) * rs + ch[q]; \
                int gi = 0; float gm = gl[0]; \
                _Pragma("unroll") for (int q = 1; q < 4; ++q) if (gl[q] > gm) { gm = gl[q]; gi = q; } \
                float gs = 0.f; \
                _Pragma("unroll") for (int q = 0; q < 4; ++q) gs += expf(gl[q] - gm); \
                const float gwt = 1.0f / gs; \
                float el[4]; \
                _Pragma("unroll") for (int q = 0; q < 4; ++q) el[q] = gi == 0 ? ex[q] : (gi == 1 ? ex[4 + q] : (gi == 2 ? ex[8 + q] : ex[12 + q])); \
                int i1 = 0; float v1 = el[0]; \
                _Pragma("unroll") for (int q = 1; q < 4; ++q) if (el[q] > v1) { v1 = el[q]; i1 = q; } \
                int i2 = -1; float v2 = -3.0e38f; \
                _Pragma("unroll") for (int q = 0; q < 4; ++q) if (q != i1 && el[q] > v2) { v2 = el[q]; i2 = q; } \
                const float e2 = expf(v2 - v1), w1 = gwt / (1.0f + e2), w2 = gwt * e2 / (1.0f + e2); \
                rtE[(rl2) * 2] = gi * 4 + i1; rtE[(rl2) * 2 + 1] = gi * 4 + i2; rtW[(rl2) * 2] = w1; rtW[(rl2) * 2 + 1] = w2; } while (0)
#define SBH() __builtin_amdgcn_sched_barrier(0)
        {
            int c_o = F.lane & 15, g_o = F.lane >> 4, l_o = F.lane; asm volatile("" : "+v"(c_o), "+v"(g_o), "+v"(l_o)); const int c = c_o, g = g_o, lane = l_o;
            const int rl = w * RPW + c, t = t0 + rl;
            const int rr = t - (t / RPB) * RPB, cls = rr < CTXL ? 1 : 0;
            const bf16* xrow = F.XS + (size_t)t * D + 8 * g;
            f32x4 acc0 = {0.f, 0.f, 0.f, 0.f}, acc1 = acc0; float ss8[8] = {0.f, 0.f, 0.f, 0.f, 0.f, 0.f, 0.f, 0.f};
            const LAS unsigned char* wscp = L + HW_WSC + (cls * D + 8 * g) * 4; const LAS unsigned char* shp = L + HW_SH + (cls * D + 8 * g) * 4;
            const LAS unsigned char* b0p = L + HW_WT + c * HW_WTS + 8 * g * 2; const LAS unsigned char* b1p = b0p + 16 * HW_WTS; const LAS unsigned char* b2p = L + HW_WT + (32 + (c & 7)) * HW_WTS + 8 * g * 2;
            u32x4 xa[8], xb[8];
            H_LD(xa, 0, 8); SBH();
            H_LD(xb, 8, 8); SBH(); H_LOGITS(xa, 0, 8); SBH();
            H_LD(xa, 16, 8); SBH(); H_LOGITS(xb, 8, 8); SBH();
            H_LD(xb, 24, 8); SBH(); H_LOGITS(xa, 16, 8); SBH();
            H_LD(xa, 0, 8); SBH(); H_LOGITS(xb, 24, 8); SBH();
            float ss = ((ss8[0] + ss8[1]) + (ss8[2] + ss8[3])) + ((ss8[4] + ss8[5]) + (ss8[6] + ss8[7])); ss += swz<16>(ss); ss = add_x32(ss);
            const float rstd = 1.0f / sqrtf(ss * (1.0f / D) + EPS);
            LAS float* LG = (LAS float*)(L + HW_LG + w * 16 * 25 * 4); LAS float* RSD = (LAS float*)(L + HW_RS + w * 64);
#pragma unroll
            for (int j = 0; j < 4; ++j) { LG[(4 * g + j) * 25 + c] = acc0[j]; if (c < 8) LG[(4 * g + j) * 25 + 16 + c] = acc1[j]; }
            if (g == 0) RSD[c] = rstd;
            bf16* ho = F.HBQ + (size_t)t * D + 8 * g;
            H_LD(xb, 8, 8); SBH(); H_OUT(xa, 0, 8); SBH();
            H_LD(xa, 16, 8); SBH(); H_OUT(xb, 8, 8); SBH();
            H_LD(xb, 24, 8); SBH(); H_OUT(xa, 16, 8); SBH();
            H_OUT(xb, 24, 8);
            asm volatile("s_waitcnt lgkmcnt(0)" ::: "memory");
            __builtin_amdgcn_wave_barrier();
            if (lane < 16) H_ROUTE(LG, RSD, lane, w * RPW + lane);
            __builtin_amdgcn_wave_barrier();
        }
        if (RPW > 16) {
            int c_o = F.lane & 15, g_o = F.lane >> 4, l_o = F.lane; asm volatile("" : "+v"(c_o), "+v"(g_o), "+v"(l_o)); const int c = c_o, g = g_o, lane = l_o;
            const int rl = (c >> 1) * RPW + 16 + (c & 1), t = t0 + rl;
            const int rr = t - (t / RPB) * RPB, cls = rr < CTXL ? 1 : 0;
            const bf16* xrow = F.XS + (size_t)t * D + 128 * w + 8 * g;
            f32x4 acc0 = {0.f, 0.f, 0.f, 0.f}, acc1 = acc0; float ss8[8] = {0.f, 0.f, 0.f, 0.f, 0.f, 0.f, 0.f, 0.f};
            const LAS unsigned char* wscp = L + HW_WSC + (cls * D + 128 * w + 8 * g) * 4; const LAS unsigned char* shp = L + HW_SH + (cls * D + 128 * w + 8 * g) * 4;
            const LAS unsigned char* b0p = L + HW_WT + c * HW_WTS + (128 * w + 8 * g) * 2; const LAS unsigned char* b1p = b0p + 16 * HW_WTS; const LAS unsigned char* b2p = L + HW_WT + (32 + (c & 7)) * HW_WTS + (128 * w + 8 * g) * 2;
            u32x4 xs[4];
            H_LD(xs, 0, 4); SBH(); H_LOGITS(xs, 0, 4); SBH();
            float ss = ((ss8[0] + ss8[1]) + (ss8[2] + ss8[3])) + ((ss8[4] + ss8[5]) + (ss8[6] + ss8[7])); ss += swz<16>(ss); ss = add_x32(ss);
            LAS float* LG = (LAS float*)(L + HW_LG + w * 16 * 25 * 4); LAS float* RSD = (LAS float*)(L + HW_RS + w * 64);
#pragma unroll
            for (int j = 0; j < 4; ++j) { LG[(4 * g + j) * 25 + c] = acc0[j]; if (c < 8) LG[(4 * g + j) * 25 + 16 + c] = acc1[j]; }
            if (g == 0) RSD[c] = ss;
            __syncthreads();
            float sst = 0.f;
#pragma unroll
            for (int w2 = 0; w2 < 8; ++w2) sst += *(const LAS float*)(L + HW_RS + w2 * 64 + c * 4);
            const float rstd = 1.0f / sqrtf(sst * (1.0f / D) + EPS);
            bf16* ho = F.HBQ + (size_t)t * D + 128 * w + 8 * g;
            H_OUT(xs, 0, 4);
            if (w == 0) {
                LAS float* LG0 = (LAS float*)(L + HW_LG); LAS float* RS2 = (LAS float*)(L + HW_RS2);
                for (int i = lane; i < 16 * 25; i += 64) { float a = LG0[i];
#pragma unroll
                    for (int w2 = 1; w2 < 8; ++w2) a += LG0[w2 * 16 * 25 + i];
                    LG0[i] = a; }
                if (g == 0) RS2[c] = rstd;
                asm volatile("s_waitcnt lgkmcnt(0)" ::: "memory");
                __builtin_amdgcn_wave_barrier();
                if (lane < 16) H_ROUTE(LG0, RS2, lane, (lane >> 1) * RPW + 16 + (lane & 1));
            }
        }
#undef H_LD
#undef H_LOGITS
#undef H_OUT
#undef H_ROUTE
#undef SBH
        __syncthreads();
        int tid = F.tid; asm volatile("" : "+v"(tid));
        if (tid < 2 * RPU) lpos[tid] = __hip_atomic_fetch_add(&lcnt[rtE[tid]], 1, __ATOMIC_RELAXED, __HIP_MEMORY_SCOPE_WORKGROUP);
        __syncthreads();
        if (tid < 16) lbase[tid] = (int)__hip_atomic_fetch_add(CNT + tid * 64, (unsigned)lcnt[tid], RLX_AGENT);
        __syncthreads();
        if (tid < 2 * RPU && !F.dry) { const int e = rtE[tid], pos = lbase[e] + lpos[tid]; F.LIST[e * T + pos] = (t0 + (tid >> 1)) * 2 + (tid & 1); F.LISTW[e * T + pos] = rtW[tid]; }
        __syncthreads();
    }
}

DI int build_tiles(Frame& F, int l) {
    make_frame(F);
    LAS int* TE = (LAS int*)(F.lds + TAB_OFF); LAS int* TR0 = TE + MAXTILES; LAS int* NEc = TR0 + MAXTILES; LAS int* NTp = NEc + 16;
    if (F.tid == 0) {
        int nt = 0;
        for (int e = 0; e < NE; ++e) { int n = (int)__hip_atomic_load((unsigned*)(F.ctl + CW_CNT + (l * 16 + e) * 64), RLX_AGENT); if (n > T) n = T; NEc[e] = n;
            for (int r0 = 0; r0 < n && nt < MAXTILES; r0 += 256) { TE[nt] = e; TR0[nt] = r0; ++nt; } }
        NTp[0] = nt;
    }
    __syncthreads();
    return __builtin_amdgcn_readfirstlane(NTp[0]);
}

DI void phase_Z(Frame& F) {
    make_frame(F);
    const int gw = F.bx * 8 + F.wave, NGW = F.G * 8;
    for (int i = gw; i < NB * SEQ; i += NGW) {
        const int b = i / SEQ, j0 = i - b * SEQ, r = CTXL + j0, t = b * RPB + r;
        f32x4 v[4]; load_xrow(F, DEPTH, t, b, r, b, v);
        const float rstd = row_rstd(v);
        f32x4* o = (f32x4*)(F.out + (size_t)i * D);
#pragma unroll
        for (int j = 0; j < 4; ++j) { const int e = F.lane + 64 * j; o[e] = v[j] * rstd * ((const f32x4*)F.final_norm_w)[e]; }
    }
}

constexpr int NPH_L = 10;
constexpr int NPHASES = 2 + DEPTH * NPH_L + 1;
__global__ void __launch_bounds__(512, 2) fwd_kernel(Args args) {
    extern __shared__ __attribute__((aligned(16))) unsigned char lds_raw[];
    Frame F; { int w_ = __builtin_amdgcn_readfirstlane((int)threadIdx.x >> 6); asm volatile("" : "+s"(w_)); F.wsg = w_; } make_frame(F);
    for (int u = F.tid; u < (LDS_BYTES - LDSCTL_OFF) / 4; u += 512) ((LAS unsigned*)(F.lds + LDSCTL_OFF))[u] = 0u;
    __syncthreads();
    volatile LAS unsigned* MISC = (volatile LAS unsigned*)(F.lds + MISC_OFF);
    XcdBarrier bar; bar.bar = (unsigned*)(F.ctl + CW_BAR); bar.x = 0; bar.st = nullptr;
#if !MK_PER_PHASE_LAUNCH
    bar = xcd_barrier_post((unsigned*)(F.ctl + CW_BAR + (args.bar_slot ? 28672 + args.bar_slot * 4096 : 0)), MISC + 8, F.tid == 0);
#endif
    const int lo = args.ph_lo, hi = args.ph_hi & 0xffff;
#define IN(k) (lo <= (k) && (k) < hi)
#if MK_PER_PHASE_LAUNCH
#define SEAM(k) do { } while (0)
#else
#define SEAM(k) do { if (IN(k) && IN((k) + 1)) { make_frame(F); xcd_barrier(bar, F.tid == 0); } } while (0)
#endif
    if (IN(0)) { phase_prologue(F); } SEAM(0);
    if (IN(1)) { phase_consts(F); } SEAM(1);
    for (int l = 0; l < DEPTH; ++l) {
        const int p0 = 2 + l * NPH_L;
        const bool lastl = (l == DEPTH - 1);
        if (IN(p0 + 0)) { phase_A(F, l); } SEAM(p0 + 0);
        if (IN(p0 + 1)) {
            make_frame(F);
            pg8::DenseSched S; S.so.init(T, NP, F.G, F.bx); S.Bt = (const char*)F.WIN; S.K = D; S.skipctx = 0;
            pg8::EpiInProj E{F.PHG, F.PREP, F.PZ, F.LB + l * 1024};
            pg8::gemm_phase<pg8::EpiInProj, pg8::DenseSched, true>(F.lds, F.tid, (const char*)F.HBQ, D, S, E);
            {
                make_frame(F);
                const int nun = (T / 256) * (NP / 256), nex = nun % F.G;
                if (nex == 0) expert_weight_transposes(F, l, F.bx, F.G, 0); else if (F.bx >= nex) expert_weight_transposes(F, l, F.bx - nex, F.G - nex, 0);
            }
        } SEAM(p0 + 1);
        if (IN(p0 + 3)) { phase_D(F, l); } SEAM(p0 + 3);
        if (IN(p0 + 4)) { phase_E_naive(F); } SEAM(p0 + 4);
        if (IN(p0 + 5)) { phase_F(F, l); } SEAM(p0 + 5);
        if (IN(p0 + 6)) {
            make_frame(F);
            pg8::DenseSched S; S.so.init(lastl ? NB * SEQ : T, D, F.G, F.bx); S.Bt = (const char*)wout_buf(F, l); S.K = D; S.skipctx = lastl ? 1 : 0;
            pg8::EpiOutProj E{F.XS, F.MOD + (size_t)l * 17 * MODW + 2 * D, F.dry ? 0.f : 1.f};
            pg8::gemm_phase<pg8::EpiOutProj, pg8::DenseSched, true>(F.lds, F.tid, (const char*)F.HBQ, D, S, E);
            {
                make_frame(F);
                const int nun = (lastl ? NB * SEQ : T) / 256 * (D / 256), nex = nun % F.G;
                const int rank = nex == 0 ? F.bx : F.bx - nex, nblk = nex == 0 ? F.G : F.G - nex;
                if (rank >= 0) { expert_weight_transposes(F, l, rank, nblk, 1); if (!lastl) inout_weight_transposes(F, l + 1, rank, nblk); }
            }
        } SEAM(p0 + 6);
        if (IN(p0 + 7)) { phase_H(F, l); } SEAM(p0 + 7);
        if (IN(p0 + 8)) {
            const int NT = build_tiles(F, l);
            LAS int* TE = (LAS int*)(F.lds + TAB_OFF);
            pg8::GroupSched<true> S{TE, TE + MAXTILES, TE + 2 * MAXTILES, NT, F.G, F.bx, (const char*)F.out + XO_WGU, (size_t)D * D * 2, D, F.LIST};
            pg8::EpiSwiGLU E{F.PREP + PREP_ACT / 2};
            pg8::gemm_phase<pg8::EpiSwiGLU, pg8::GroupSched<true>, true>(F.lds, F.tid, (const char*)F.HBQ, D, S, E);
        } SEAM(p0 + 8);
        if (IN(p0 + 9)) {
            const int NT = build_tiles(F, l);
            LAS int* TE = (LAS int*)(F.lds + TAB_OFF);
            pg8::GroupSched<false> S{TE, TE + MAXTILES, TE + 2 * MAXTILES, NT, F.G, F.bx, (const char*)F.out + XO_WDN, (size_t)D * FF * 2, FF, F.LIST};
            pg8::EpiDown E{F.PHG, F.LIST, F.LISTW, F.lds};
            pg8::gemm_phase<pg8::EpiDown, pg8::GroupSched<false>, true>(F.lds, F.tid, (const char*)(F.PREP + PREP_ACT / 2), FF, S, E);
        } SEAM(p0 + 9);
    }
    if (IN(NPHASES - 1)) { phase_Z(F); }
#undef IN
#undef SEAM
}

extern "C" void kernel_launch(void* const* d_in, const int* in_sizes, int n_in, void* d_out, int out_size, void* d_ws, size_t ws_size, hipStream_t stream) {
    static int grid = 0;
    if (grid == 0) {
        if (n_in != 24 || out_size != NB * SEQ * D || ws_size < WS_END) { fprintf(stderr, "kernel_launch: unexpected problem (n_in %d, out %d, ws %zu < %zu)\n", n_in, out_size, ws_size, (size_t)WS_END); grid = -1; return; }
        int dev = 0, cus = 0, per_cu = 0;
        if (hipGetDevice(&dev) != hipSuccess || hipDeviceGetAttribute(&cus, hipDeviceAttributeMultiprocessorCount, dev) != hipSuccess) { grid = -1; return; }
        if (hipFuncSetAttribute((const void*)fwd_kernel, hipFuncAttributeMaxDynamicSharedMemorySize, LDS_BYTES) != hipSuccess) { fprintf(stderr, "kernel_launch: hipFuncSetAttribute failed\n"); grid = -1; return; }
        if (hipOccupancyMaxActiveBlocksPerMultiprocessor(&per_cu, (const void*)fwd_kernel, 512, LDS_BYTES) != hipSuccess || per_cu < 1) { fprintf(stderr, "kernel_launch: occupancy query says %d\n", per_cu); }
        (void)hipGetLastError();
        grid = cus;
    }
    if (grid < 0) return;
    if (hipMemsetAsync((char*)d_ws + WS_CTL, 0, CTL_ZERO_BYTES, stream) != hipSuccess) return;
    Args a{};
    for (int i = 0; i < 24; ++i) a.in[i] = (const float*)d_in[i];
    a.out = (float*)d_out; a.ws = (unsigned char*)d_ws;
#if MK_PER_PHASE_LAUNCH
    for (int p = 0; p < NPHASES; ++p) {
        a.ph_lo = p; a.ph_hi = p + 1;
        hipLaunchKernelGGL(fwd_kernel, dim3(grid), dim3(512), LDS_BYTES, stream, a);
    }
#elif MK_PROBE >= 0
    {
        int cur = 0, slot = 0;
        for (int l = 0; l < DEPTH; ++l) { const int p = 2 + l * NPH_L + MK_PROBE;
            a.ph_lo = cur; a.ph_hi = p + 1; a.bar_slot = slot++; hipLaunchKernelGGL(fwd_kernel, dim3(grid), dim3(512), LDS_BYTES, stream, a);
            for (int r = 0; r < MK_PROBE_REP; ++r) { a.ph_lo = p; a.ph_hi = (p + 1) | (MK_PROBE_DRY << 16); a.bar_slot = slot++; hipLaunchKernelGGL(fwd_kernel, dim3(grid), dim3(512), LDS_BYTES, stream, a); }
            cur = p + 1; }
        a.ph_lo = cur; a.ph_hi = NPHASES; a.bar_slot = slot++; hipLaunchKernelGGL(fwd_kernel, dim3(grid), dim3(512), LDS_BYTES, stream, a);
    }
#else
    a.ph_lo = 0; a.ph_hi = NPHASES; a.bar_slot = 0;
    hipLaunchKernelGGL(fwd_kernel, dim3(grid), dim3(512), LDS_BYTES, stream, a);
#endif
}
```

```cpp
#include <hip/hip_runtime.h>
#include <cstdio>
#include <cstdint>

#ifndef MK_PROBE
#define MK_PROBE (-1)
#define MK_PROBE_DRY 0
#define MK_PROBE_REP 1
#endif
#ifndef MK_PER_PHASE_LAUNCH
#define MK_PER_PHASE_LAUNCH 0
#endif

#define DI __device__ __forceinline__
#define LAS __attribute__((address_space(3)))
#define GAS __attribute__((address_space(1)))
typedef unsigned short bf16;
typedef short bf16x8 __attribute__((ext_vector_type(8)));
typedef float f32x4 __attribute__((ext_vector_type(4)));
typedef float f32x2 __attribute__((ext_vector_type(2)));
typedef unsigned u32x4 __attribute__((ext_vector_type(4)));
typedef unsigned u32x2 __attribute__((ext_vector_type(2)));
typedef GAS unsigned gu32;

constexpr int D = 1024, NB = 16, SEQ = 2048, CTXL = 256, RPB = SEQ + CTXL, T = NB * RPB, DEPTH = 4;
constexpr int INC = 4624, NP = 4608;
constexpr int HD = 128;
constexpr int NE = 16, FF = 512;
constexpr float EPS = 1e-6f;
constexpr int MODW = 6 * D;

constexpr size_t MiB = 1u << 20;
constexpr size_t WS_CTL = 0, CTL_ZERO_BYTES = 1 * MiB;
constexpr size_t WS_MOD = 1 * MiB;
constexpr size_t WS_LB = 3 * MiB;
constexpr size_t WS_CA = 3 * MiB + 64 * 1024;
constexpr size_t WS_CH = 3 * MiB + 96 * 1024;
constexpr size_t WS_BETA = 4 * MiB;
constexpr size_t WS_LOGA = 5 * MiB + 256 * 1024;
constexpr size_t WS_CUM = 6 * MiB + 512 * 1024;
constexpr size_t WS_LIST = 8 * MiB;
constexpr size_t WS_LISTW = 11 * MiB;
constexpr size_t WS_WIN = 14 * MiB;
constexpr size_t WS_WOUT = 23 * MiB;
constexpr size_t WS_XS = 26 * MiB;
constexpr size_t WS_HBQ = 170 * MiB;
constexpr size_t WS_PHG = 278 * MiB;
constexpr size_t WS_PZ = 458 * MiB;
constexpr size_t WS_PREP = 494 * MiB;
constexpr size_t WS_QKD = 674 * MiB;
constexpr size_t WS_END = 710 * MiB;
constexpr size_t PREP_RAW = 0, PREP_U = 108 * MiB;
constexpr size_t XSLOT_W = 72 * MiB;
constexpr size_t HBQ_QKN = 0, HBQ_QKD = 72 * MiB;
constexpr size_t PREP_WGU = 0, PREP_WDN = 32 * MiB, PREP_ACT = 48 * MiB;
constexpr int MAXTILES = 304;

constexpr int CW_TMO = 0, CW_CODE = 1;
constexpr int CW_BAR = 4096;
constexpr int CW_CNT = 16384;

constexpr int RING_BYTES = 131072;
constexpr int LDSCTL_OFF = RING_BYTES, MISC_OFF = LDSCTL_OFF + 320;
constexpr int TAB_OFF = LDSCTL_OFF + 1024;
constexpr int LDS_BYTES = 147456;

#define RLX_AGENT __ATOMIC_RELAXED, __HIP_MEMORY_SCOPE_AGENT
#define LDS_WAIT() asm volatile("s_waitcnt lgkmcnt(0)" ::: "memory")
#define VM_WAIT() asm volatile("s_waitcnt vmcnt(0)" ::: "memory")

DI float bf2f(unsigned short b) { return __uint_as_float(((unsigned)b) << 16); }
DI unsigned cvt_pk_bf16(float lo, float hi) { unsigned r; asm volatile("v_cvt_pk_bf16_f32 %0, %1, %2" : "=v"(r) : "v"(lo), "v"(hi)); return r; }
DI float bflo(unsigned w) { return __uint_as_float(w << 16); }
DI float bfhi(unsigned w) { return __uint_as_float(w & 0xffff0000u); }
DI float silu_f(float x) { return x * __builtin_amdgcn_rcpf(1.0f + __expf(-x)); }
DI float sigmoid_f(float x) { return __builtin_amdgcn_rcpf(1.0f + __expf(-x)); }
DI float softplus_f(float x) { const float e = __expf(-fabsf(x)); return fmaxf(x, 0.f) + (e < 0.01f ? e * (1.0f - e * (0.5f - 0.33333333f * e)) : __logf(1.0f + e)); }
template <int M> DI float swz(float v) { static_assert(M >= 1 && M <= 16, "xor mask"); return __int_as_float(__builtin_amdgcn_ds_swizzle(__float_as_int(v), (M << 10) | 0x1f)); }
DI float pair32(float a, float b) { auto r = __builtin_amdgcn_permlane32_swap(__float_as_uint(a), __float_as_uint(b), false, false); return __uint_as_float(r[0]) + __uint_as_float(r[1]); }
DI float add_x32(float v) { return pair32(v, v); }
DI float lane_get(float v, int src) { return __int_as_float(__builtin_amdgcn_ds_bpermute(src << 2, __float_as_int(v))); }
DI float wave_sum(float v) {
    v += swz<1>(v); v += swz<2>(v); v += swz<4>(v); v += swz<8>(v); v += swz<16>(v);
    return add_x32(v);
}

typedef short s16x4 __attribute__((ext_vector_type(4)));
typedef __bf16 bf16x2_t __attribute__((ext_vector_type(2)));
DI unsigned cvtpk(float lo, float hi) { f32x2 v = {lo, hi}; bf16x2_t b = __builtin_convertvector(v, bf16x2_t); return __builtin_bit_cast(unsigned, b); }
constexpr size_t PHG_G = (size_t)NB * 4 * 2304 * 512;
DI size_t phg_idx(int b, int h, int r) { return ((size_t)(b * 4 + h) * 2304 + r) * 512; }
DI size_t wu_idx(int dir, int b, int h, int srow) { return ((size_t)((dir * NB + b) * 4 + h) * 2304 + srow) * 128; }
DI size_t qkn_idx(int b, int h, int r) { return ((size_t)(b * 4 + h) * 2304 + r) * 384; }
DI s16x4 ds_tr(const LAS unsigned char* p) { return __builtin_bit_cast(s16x4, __builtin_amdgcn_ds_read_tr16_b64_v4i16((LAS s16x4*)p)); }
DI bf16x8 cat8(s16x4 a, s16x4 b) { return __builtin_shufflevector(a, b, 0, 1, 2, 3, 4, 5, 6, 7); }
DI bf16x8 pack8(float a0, float a1, float a2, float a3, float a4, float a5, float a6, float a7) { u32x4 w; w.x = cvtpk(a0, a1); w.y = cvtpk(a2, a3); w.z = cvtpk(a4, a5); w.w = cvtpk(a6, a7); return __builtin_bit_cast(bf16x8, w); }
#define MFMA16(a, b, c) __builtin_amdgcn_mfma_f32_16x16x32_bf16((a), (b), (c), 0, 0, 0)

namespace pg8 {
constexpr int BM = 256, BK = 64, HALF = 128, HTB = HALF * BK * 2, STAGE_BYTES = 8 * HTB, NXCD = 8, WGM = 8;
__host__ __device__ __forceinline__ int lds_byte(int r, int c) { const int st = (r >> 4) * 2 + (c >> 5), rr = r & 15, cc = c & 31, ob = rr * 64 + cc * 2; return st * 1024 + (ob ^ (((ob >> 9) & 1) << 5)); }
__host__ __device__ __forceinline__ void stage_rc(int b, int& R, int& C) { const int st = b / 1024, sb = b % 1024, swz = sb ^ (((sb >> 9) & 1) << 5); R = (st >> 1) * 16 + swz / 64; C = (st & 1) * 32 + (swz % 64) / 2; }
__host__ __device__ __forceinline__ int perm32(int rho) { const int n = rho >> 4, i = rho & 15; return 8 * (i >> 2) + 4 * n + (i & 3); }

struct Unit { int pm, pn, e, r0, ne; };

struct StaticOrder {
    int nM, nN, nwg, G, c;
    __device__ void init(int M, int N, int G_, int c_) { nM = M / BM; nN = N / BM; nwg = nM * nN; G = G_; c = c_; }
    __device__ bool next(int i, Unit& u) const {
        const long L = (long)i * G + c; if (L >= nwg) return false;
        int wgid = (int)L; { const int q = nwg / NXCD, r = nwg % NXCD, xcd = wgid % NXCD, off = wgid / NXCD; wgid = (xcd < r ? xcd * (q + 1) : r * (q + 1) + (xcd - r) * q) + off; }
        const int nig = WGM * nN, gid = wgid / nig, fm = gid * WGM, gsz = (nM - fm) < WGM ? (nM - fm) : WGM;
        u.pm = fm + ((wgid % nig) % gsz); u.pn = (wgid % nig) / gsz; u.e = 0; u.r0 = 0; u.ne = 0; return true;
    }
};
struct DenseSched {
    StaticOrder so; const char* Bt; int K; int skipctx;
    DI bool next(int i, Unit& u) const { if (!so.next(i, u)) return false; if (skipctx) u.pm = u.pm + u.pm / 8 + 1; return true; }
    DI const char* bptr(const Unit& u) const { return Bt + (size_t)u.pn * BM * K * 2; }
    DI unsigned arow(const Unit& u, int row) const { return (unsigned)(u.pm * BM + row) * (unsigned)(K * 2); }
};
template <bool GATHER> struct GroupSched {
    const LAS int* TE; const LAS int* TR0; const LAS int* NEc; int NT, G, c; const char* Bt; size_t bstride; int K; const int* LIST;
    DI bool next(int i, Unit& u) const {
        const int L = i * G + c; if (L >= NT * 4) return false;
        const int ti = L >> 2; u.pm = ti; u.pn = L & 3;
        u.e = __builtin_amdgcn_readfirstlane(TE[ti]); u.r0 = __builtin_amdgcn_readfirstlane(TR0[ti]); u.ne = __builtin_amdgcn_readfirstlane(NEc[u.e]); return true;
    }
    DI const char* bptr(const Unit& u) const { return Bt + (size_t)u.e * bstride + (size_t)u.pn * BM * K * 2; }
    DI unsigned arow(const Unit& u, int row) const {
        if (GATHER) { const int pos = u.r0 + row; int tok = 0; if (pos < u.ne) tok = LIST[u.e * T + pos] >> 1; return (unsigned)tok * (unsigned)(K * 2); }
        else return (unsigned)(u.pm * BM + row) * (unsigned)(K * 2);
    }
};

template <class Epi, class Sched, bool ALIGN_EPI>
DI void gemm_phase(LAS unsigned char* lds, const int tid_in, const char* Abase, const int K, const Sched& S, const Epi& E) {
    int tid_ = tid_in; asm volatile("" : "+v"(tid_));
    const int tid = tid_, wid = __builtin_amdgcn_readfirstlane(tid >> 6), lane = tid & 63, wr = wid >> 2, wc = wid & 3, fr = lane & 15, fq = lane >> 4;
    const int nt = K / BK;
    int Rr[2]; unsigned Cb[2], voffB[2];
#pragma unroll
    for (int i = 0; i < 2; ++i) { int R, C; stage_rc(tid * 16 + i * 8192, R, C); const int Rb = Epi::PERM ? ((R & ~31) + perm32(R & 31)) : R;
        Rr[i] = R; Cb[i] = (unsigned)C * 2u; voffB[i] = (unsigned)(Rb * K + C) * 2u; }
    const size_t kstep = (size_t)(BK * 2);
    const size_t hstepB = (size_t)HALF * K * 2;
    const unsigned ldsw = (unsigned)wid * 1024u;
    const int aoff = lds_byte(wr * 64 + fr, fq * 8), boff = lds_byte(wc * 32 + fr, fq * 8);
#define PG8_SA(b, h) (((b) * 2 + (h)) * HTB)
#define PG8_SB(b, h) ((4 + (b) * 2 + (h)) * HTB)
#define PG8_STAGE_B(bufoff, gbase) do { _Pragma("unroll") for (int _i = 0; _i < 2; ++_i) \
        __builtin_amdgcn_global_load_lds((const unsigned*)((const char*)(gbase) + voffB[_i]), (LAS unsigned*)(lds + (bufoff) + ldsw + _i * 8192), 16, 0, 0); } while (0)
#define PG8_STAGE_A(bufoff, offs, kb) do { _Pragma("unroll") for (int _i = 0; _i < 2; ++_i) \
        __builtin_amdgcn_global_load_lds((const unsigned*)((const char*)(Abase + (kb)) + (offs)[_i]), (LAS unsigned*)(lds + (bufoff) + ldsw + _i * 8192), 16, 0, 0); } while (0)
#define PG8_LDA(dst, b, h) do { _Pragma("unroll") for (int m = 0; m < 4; ++m) _Pragma("unroll") for (int k = 0; k < 2; ++k) dst[m][k] = *(const LAS bf16x8*)(lds + PG8_SA(b, h) + aoff + m * 2048 + k * 1024); } while (0)
#define PG8_LDB(dst, b, h) do { _Pragma("unroll") for (int n = 0; n < 2; ++n) _Pragma("unroll") for (int k = 0; k < 2; ++k) dst[n][k] = *(const LAS bf16x8*)(lds + PG8_SB(b, h) + boff + n * 2048 + k * 1024); } while (0)
#define PG8_MMA(ai, bj, At, Bt) do { __builtin_amdgcn_s_setprio(1); _Pragma("unroll") for (int m = 0; m < 4; ++m) _Pragma("unroll") for (int n = 0; n < 2; ++n) _Pragma("unroll") for (int k = 0; k < 2; ++k) \
        acc[ai][bj][m][n] = __builtin_amdgcn_mfma_f32_16x16x32_bf16(Bt[n][k], At[m][k], acc[ai][bj][m][n], 0, 0, 0); __builtin_amdgcn_s_setprio(0); } while (0)
#define PG8_WAIT_V(n) asm volatile("s_waitcnt vmcnt(" #n ")" ::: "memory")
#define PG8_WAIT_L(n) asm volatile("s_waitcnt lgkmcnt(" #n ")" ::: "memory")
#define PG8_BAR __builtin_amdgcn_s_barrier()
#define PG8_SCHED __builtin_amdgcn_sched_barrier(0)
    Unit cur, nxt; int ui = 0;
    if (!S.next(0, cur)) return;
    f32x4 acc[2][2][4][2];
#pragma unroll
    for (int a = 0; a < 2; ++a)
#pragma unroll
        for (int b = 0; b < 2; ++b)
#pragma unroll
            for (int m = 0; m < 4; ++m)
#pragma unroll
                for (int n = 0; n < 2; ++n) acc[a][b][m][n] = (f32x4){0.f, 0.f, 0.f, 0.f};
    bf16x8 At[4][2], B0[2][2], B1[2][2];
    unsigned cA0[2], cA1[2], nA0[2], nA1[2];
#pragma unroll
    for (int i = 0; i < 2; ++i) { cA0[i] = S.arow(cur, Rr[i]) + Cb[i]; cA1[i] = S.arow(cur, HALF + Rr[i]) + Cb[i]; }
    const char* cB = S.bptr(cur);
    PG8_STAGE_B(PG8_SB(0, 0), cB); PG8_STAGE_B(PG8_SB(0, 1), cB + hstepB); PG8_STAGE_A(PG8_SA(0, 0), cA0, 0); PG8_STAGE_A(PG8_SA(0, 1), cA1, 0);
    if (wr == 1) PG8_BAR;
    PG8_WAIT_V(2); PG8_BAR;
    PG8_STAGE_B(PG8_SB(1, 0), cB + kstep); PG8_STAGE_A(PG8_SA(1, 0), cA0, kstep); PG8_STAGE_B(PG8_SB(1, 1), cB + hstepB + kstep);
    PG8_WAIT_V(6); PG8_BAR;
    for (;;) {
        const bool has_next = S.next(ui + 1, nxt);
        u32x2 pre_ = {0u, 0u}; if constexpr (Epi::HAS_PRE) pre_ = E.pre_load(cur, tid);
        const char* nB = cB;
#pragma unroll
        for (int i = 0; i < 2; ++i) { nA0[i] = cA0[i]; nA1[i] = cA1[i]; }
        if (has_next) { nB = S.bptr(nxt);
#pragma unroll
            for (int i = 0; i < 2; ++i) { nA0[i] = S.arow(nxt, Rr[i]) + Cb[i]; nA1[i] = S.arow(nxt, HALF + Rr[i]) + Cb[i]; } }
        for (int t = 0; t < nt; t += 2) {
            const bool last = (t == nt - 2);
            const size_t kb1 = (size_t)(t + 1) * kstep;
            const size_t kb2 = last ? (size_t)0 : (size_t)(t + 2) * kstep, kb3 = kb2 + kstep;
            const char* b2 = last ? nB : cB + kb2; const char* b3 = b2 + kstep;
            unsigned a2h0[2], a2h1[2];
#pragma unroll
            for (int i = 0; i < 2; ++i) { a2h0[i] = last ? nA0[i] : cA0[i]; a2h1[i] = last ? nA1[i] : cA1[i]; }
            PG8_LDB(B0, 0, 0); PG8_LDB(B1, 0, 1); PG8_SCHED; PG8_LDA(At, 0, 0); PG8_STAGE_A(PG8_SA(1, 1), cA1, kb1);
            PG8_WAIT_V(8); PG8_WAIT_L(0); PG8_BAR; PG8_MMA(0, 0, At, B0); PG8_MMA(0, 1, At, B1); PG8_BAR; PG8_SCHED;
            PG8_LDA(At, 0, 1); PG8_STAGE_B(PG8_SB(0, 0), b2); PG8_STAGE_B(PG8_SB(0, 1), b2 + hstepB); PG8_STAGE_A(PG8_SA(0, 0), a2h0, kb2);
            PG8_WAIT_V(8); PG8_WAIT_L(0); PG8_BAR; PG8_MMA(1, 0, At, B0); PG8_MMA(1, 1, At, B1); PG8_BAR; PG8_SCHED;
            PG8_LDB(B0, 1, 0); PG8_LDB(B1, 1, 1); PG8_SCHED; PG8_LDA(At, 1, 0); PG8_STAGE_A(PG8_SA(0, 1), a2h1, kb2);
            PG8_WAIT_V(8); PG8_WAIT_L(0); PG8_BAR; PG8_MMA(0, 0, At, B0); PG8_MMA(0, 1, At, B1); PG8_BAR; PG8_SCHED;
            PG8_LDA(At, 1, 1); PG8_STAGE_B(PG8_SB(1, 0), b3); PG8_STAGE_B(PG8_SB(1, 1), b3 + hstepB); PG8_STAGE_A(PG8_SA(1, 0), a2h0, kb3);
            PG8_WAIT_V(8); PG8_WAIT_L(0); PG8_BAR; PG8_MMA(1, 0, At, B0); PG8_MMA(1, 1, At, B1); PG8_BAR; PG8_SCHED;
        }
        if constexpr (ALIGN_EPI) { if (wr == 0) PG8_BAR; }
        if constexpr (Epi::HAS_PRE) { static_assert(ALIGN_EPI, "the extra barrier needs the aligned wave groups"); E.pre_store(tid, pre_); PG8_WAIT_L(0); PG8_BAR; }
        E(acc, cur, wr, wc, fr, fq);
        if (!has_next) break;
#pragma unroll
        for (int a = 0; a < 2; ++a)
#pragma unroll
            for (int b = 0; b < 2; ++b)
#pragma unroll
                for (int m = 0; m < 4; ++m)
#pragma unroll
                    for (int n = 0; n < 2; ++n) acc[a][b][m][n] = (f32x4){0.f, 0.f, 0.f, 0.f};
        cur = nxt; cB = nB; ++ui;
#pragma unroll
        for (int i = 0; i < 2; ++i) { cA0[i] = nA0[i]; cA1[i] = nA1[i]; }
        if constexpr (ALIGN_EPI) { if (wr == 1) PG8_BAR; }
    }
    PG8_WAIT_V(0);
    if constexpr (!ALIGN_EPI) { if (wr == 0) PG8_BAR; }
    PG8_BAR;
#undef PG8_SA
#undef PG8_SB
#undef PG8_STAGE_A
#undef PG8_STAGE_B
#undef PG8_LDA
#undef PG8_LDB
#undef PG8_MMA
#undef PG8_WAIT_V
#undef PG8_WAIT_L
#undef PG8_BAR
#undef PG8_SCHED
}

DI float logf_gate(float x, float lb) {
    const float sg = __builtin_amdgcn_rcpf(1.0f + __expf(-fmaxf(x, -80.0f)));
    return __builtin_amdgcn_logf(lb + (1.0f - lb) * sg) * 0.69314718056f;
}
struct EpiInProj {
    static constexpr bool PERM = true; static constexpr bool HAS_PRE = false;
    bf16* PHG; bf16* RAW; bf16* PZ; const float* LB;
    DI void operator()(const f32x4 (&acc)[2][2][4][2], const Unit& u, int wr, int wc, int fr, int fq) const {
        const int colu = u.pn * BM; int row0 = u.pm * BM + wr * 64 + fr;
        bf16* base; int ld, cbase, mode; size_t bjstep = HALF;
        if (colu < 2560) { const int blk = colu >> 9; mode = blk == 0 ? 1 : (blk >= 3 ? 2 : 0);
            if (blk == 2) { base = PHG + PHG_G; ld = 512; cbase = colu - 1024; }
            else { const int b = (u.pm * BM) / 2304, slot = blk == 0 ? 0 : (blk == 1 ? 1 : blk - 1);
                base = PHG + phg_idx(b, (colu & 511) >> 7, 0) + slot * 128; ld = 512; cbase = 0; row0 -= b * 2304; bjstep = (size_t)2304 * 512; } }
        else if (colu < 4096) { base = RAW; ld = 1536; cbase = colu - 2560; mode = 0; }
        else { base = PZ; ld = 512; cbase = colu - 4096; mode = 0; }
        const int lcol = wc * 32 + 8 * fq;
        if (mode == 2) {
            float lbv[2][8];
#pragma unroll
            for (int bj = 0; bj < 2; ++bj)
#pragma unroll
                for (int j = 0; j < 8; ++j) lbv[bj][j] = LB[(colu - 1536) + bj * HALF + lcol + j];
#pragma unroll
            for (int ai = 0; ai < 2; ++ai)
#pragma unroll
                for (int m = 0; m < 4; ++m) { bf16* rowp = base + (size_t)(row0 + ai * HALF + m * 16) * ld + cbase + lcol;
#pragma unroll
                    for (int bj = 0; bj < 2; ++bj) { const f32x4 v0 = acc[ai][bj][m][0], v1 = acc[ai][bj][m][1]; u32x4 w;
                        w.x = cvt_pk_bf16(logf_gate(v0[0], lbv[bj][0]), logf_gate(v0[1], lbv[bj][1])); w.y = cvt_pk_bf16(logf_gate(v0[2], lbv[bj][2]), logf_gate(v0[3], lbv[bj][3]));
                        w.z = cvt_pk_bf16(logf_gate(v1[0], lbv[bj][4]), logf_gate(v1[1], lbv[bj][5])); w.w = cvt_pk_bf16(logf_gate(v1[2], lbv[bj][6]), logf_gate(v1[3], lbv[bj][7]));
                        *(u32x4*)(rowp + bj * bjstep) = w; } }
        } else {
#pragma unroll
            for (int ai = 0; ai < 2; ++ai)
#pragma unroll
                for (int m = 0; m < 4; ++m) { bf16* rowp = base + (size_t)(row0 + ai * HALF + m * 16) * ld + cbase + lcol;
#pragma unroll
                    for (int bj = 0; bj < 2; ++bj) { f32x4 v0 = acc[ai][bj][m][0], v1 = acc[ai][bj][m][1];
                        if (mode == 1) {
#pragma unroll
                            for (int j = 0; j < 4; ++j) { v0[j] = silu_f(v0[j]); v1[j] = silu_f(v1[j]); } }
                        u32x4 w; w.x = cvt_pk_bf16(v0[0], v0[1]); w.y = cvt_pk_bf16(v0[2], v0[3]); w.z = cvt_pk_bf16(v1[0], v1[1]); w.w = cvt_pk_bf16(v1[2], v1[3]);
                        *(u32x4*)(rowp + bj * bjstep) = w; } }
        }
    }
};
struct EpiOutProj {
    static constexpr bool PERM = true; static constexpr bool HAS_PRE = false;
    bf16* XS; const float* g1base; float gsc;
    DI void operator()(const f32x4 (&acc)[2][2][4][2], const Unit& u, int wr, int wc, int fr, int fq) const {
        const int row0 = u.pm * BM + wr * 64 + fr, col0 = u.pn * BM + wc * 32 + 8 * fq;
        const int bb = u.pm / 9, modrow = (u.pm - bb * 9 == 0) ? 16 : bb;
        const float* g = g1base + (size_t)modrow * MODW;
        f32x4 gv[2][2];
#pragma unroll
        for (int bj = 0; bj < 2; ++bj)
#pragma unroll
            for (int n = 0; n < 2; ++n) gv[bj][n] = *(const f32x4*)(g + col0 + bj * HALF + 4 * n) * gsc;
#pragma unroll
        for (int ai = 0; ai < 2; ++ai)
#pragma unroll
            for (int m = 0; m < 4; ++m) { bf16* rowp = XS + (size_t)(row0 + ai * HALF + m * 16) * D + col0;
#pragma unroll
                for (int bj = 0; bj < 2; ++bj) { u32x4* p = (u32x4*)(rowp + bj * HALF); const u32x4 x = *p; const f32x4 a0 = gv[bj][0] * acc[ai][bj][m][0], a1 = gv[bj][1] * acc[ai][bj][m][1];
                    u32x4 o; o.x = cvt_pk_bf16(bflo(x.x) + a0[0], bfhi(x.x) + a0[1]); o.y = cvt_pk_bf16(bflo(x.y) + a0[2], bfhi(x.y) + a0[3]);
                    o.z = cvt_pk_bf16(bflo(x.z) + a1[0], bfhi(x.z) + a1[1]); o.w = cvt_pk_bf16(bflo(x.w) + a1[2], bfhi(x.w) + a1[3]); *p = o; }
                asm volatile("" ::: "memory"); }
    }
};
struct EpiSwiGLU {
    static constexpr bool PERM = true; static constexpr bool HAS_PRE = false;
    bf16* ACT;
    DI void operator()(const f32x4 (&acc)[2][2][4][2], const Unit& u, int wr, int wc, int fr, int fq) const {
        const int row0 = u.pm * BM + wr * 64 + fr, col0 = u.pn * HALF + wc * 32 + 8 * fq;
#pragma unroll
        for (int ai = 0; ai < 2; ++ai)
#pragma unroll
            for (int m = 0; m < 4; ++m) { bf16* rowp = ACT + (size_t)(row0 + ai * HALF + m * 16) * FF + col0;
                const f32x4 g0 = acc[ai][0][m][0], g1 = acc[ai][0][m][1], u0 = acc[ai][1][m][0], u1 = acc[ai][1][m][1];
                u32x4 w; w.x = cvt_pk_bf16(silu_f(g0[0]) * u0[0], silu_f(g0[1]) * u0[1]); w.y = cvt_pk_bf16(silu_f(g0[2]) * u0[2], silu_f(g0[3]) * u0[3]);
                w.z = cvt_pk_bf16(silu_f(g1[0]) * u1[0], silu_f(g1[1]) * u1[1]); w.w = cvt_pk_bf16(silu_f(g1[2]) * u1[2], silu_f(g1[3]) * u1[3]);
                *(u32x4*)rowp = w; }
    }
};
struct EpiDown {
    static constexpr bool PERM = true; static constexpr bool HAS_PRE = true;
    static constexpr int EPT_OFF = 143360;
    bf16* Y; const int* LIST; const float* LISTW; LAS unsigned char* lds;
    DI u32x2 pre_load(const Unit& u, int tid) const { u32x2 r = {0u, 0u}; const int pos = u.r0 + tid;
        if (tid < 256 && pos < u.ne) { r.x = (unsigned)LIST[u.e * T + pos]; r.y = __float_as_uint(LISTW[u.e * T + pos]); } return r; }
    DI void pre_store(int tid, const u32x2& r) const { if (tid < 256) *(LAS u32x2*)(lds + EPT_OFF + tid * 8) = r; }
    DI void operator()(const f32x4 (&acc)[2][2][4][2], const Unit& u, int wr, int wc, int fr, int fq) const {
        const int rl0 = wr * 64 + fr, col0 = u.pn * BM + wc * 32 + 8 * fq;
#pragma unroll
        for (int ai = 0; ai < 2; ++ai)
#pragma unroll
            for (int m = 0; m < 4; ++m) { const int rl = rl0 + ai * HALF + m * 16, pos = u.r0 + rl;
                if (pos < u.ne) { const u32x2 ew = *(const LAS u32x2*)(lds + EPT_OFF + rl * 8); const int ent = (int)ew.x; const float w = __uint_as_float(ew.y);
                    bf16* rowp = Y + ((size_t)(ent & 1) * T + (size_t)(ent >> 1)) * D + col0;
#pragma unroll
                    for (int bj = 0; bj < 2; ++bj) { const f32x4 v0 = acc[ai][bj][m][0] * w, v1 = acc[ai][bj][m][1] * w;
                        u32x4 q; q.x = cvt_pk_bf16(v0[0], v0[1]); q.y = cvt_pk_bf16(v0[2], v0[3]); q.z = cvt_pk_bf16(v1[0], v1[1]); q.w = cvt_pk_bf16(v1[2], v1[3]);
                        *(u32x4*)(rowp + bj * HALF) = q; } } }
    }
};
}

#define XB_TMO      128
#define XB_XCNT(j)  (256  + 64 * (j))
#define XB_XSUB(j)  (1280 + 64 * (j))
#define XB_XGEN(j)  (2304 + 64 * (j))
#define XB_TOP      3328
#define XB_TOPGEN   3392
#define XCD_BAR_WORDS 3456
#define XB_SPIN_CAP (1u << 18)
DI unsigned xb_ld(unsigned* p)              { return __hip_atomic_load(p, __ATOMIC_RELAXED, __HIP_MEMORY_SCOPE_AGENT); }
DI unsigned xb_add(unsigned* p, unsigned v) { return __hip_atomic_fetch_add(p, v, __ATOMIC_RELAXED, __HIP_MEMORY_SCOPE_AGENT); }
DI unsigned xb_xcc_id() { return (unsigned)__builtin_amdgcn_s_getreg((3 << 11) | 20) & 0xFu; }
#define XB_SPIN(cond, bar) do { unsigned _sp = 0; while (cond) { __builtin_amdgcn_s_sleep(1); \
    if ((++_sp & 255u) == 0u) { if (xb_ld(&(bar)[XB_TMO])) break; if (_sp > XB_SPIN_CAP) { atomicAdd(&(bar)[XB_TMO], 1u); break; } } } } while (0)
struct XcdBarrier { unsigned* bar; unsigned x; volatile LAS unsigned* st; };
DI XcdBarrier xcd_barrier_post(unsigned* bar, volatile LAS unsigned* st, bool leader) {
    XcdBarrier b; b.bar = bar; b.x = xb_xcc_id(); b.st = st;
    if (leader) (void)xb_add(&bar[XB_XCNT(b.x)], 1u);
    return b;
}
DI void xcd_barrier_complete(unsigned* bar, unsigned x, unsigned& nloc, unsigned& nx) {
    const unsigned G = gridDim.x * gridDim.y * gridDim.z;
    unsigned sum, cnt, mine, sp = 0u;
    for (;;) {
        sum = 0u; cnt = 0u; mine = 0u;
#pragma unroll
        for (unsigned j = 0; j < 16; ++j) { const unsigned c = xb_ld(&bar[XB_XCNT(j)]); sum += c; cnt += (c > 0u) ? 1u : 0u; mine = (j == x) ? c : mine; }
        if (sum == G) break;
        __builtin_amdgcn_s_sleep(1);
        if ((++sp & 255u) == 0u) { if (xb_ld(&bar[XB_TMO])) break; if (sp > XB_SPIN_CAP) { atomicAdd(&bar[XB_TMO], 1u); break; } }
    }
    nloc = mine > 0u ? mine : 1u; nx = cnt > 0u ? cnt : 1u;
}
DI void xcd_barrier(const XcdBarrier& b, bool leader) {
    asm volatile("s_waitcnt vmcnt(0)" ::: "memory");
    __syncthreads();
    if (leader) {
        unsigned* bar = b.bar;
        __builtin_amdgcn_s_waitcnt(0);
        unsigned nloc = b.st[0], nx = b.st[1];
        if (nloc == 0u) { xcd_barrier_complete(bar, b.x, nloc, nx); b.st[0] = nloc; b.st[1] = nx; }
        const unsigned old = xb_add(&bar[XB_XSUB(b.x)], 1u);
        const unsigned gen = old / nloc;
        if (old + 1u == (gen + 1u) * nloc) {
            __builtin_amdgcn_fence(__ATOMIC_RELEASE, "agent");
            asm volatile("s_waitcnt vmcnt(0)" ::: "memory");
            const unsigned og = xb_add(&bar[XB_TOP], 1u);
            const unsigned tg = og / nx;
            if (og + 1u == (tg + 1u) * nx) xb_add(&bar[XB_TOPGEN], 1u);
            else XB_SPIN(xb_ld(&bar[XB_TOPGEN]) == tg, bar);
            __builtin_amdgcn_fence(__ATOMIC_ACQUIRE, "agent");
            xb_add(&bar[XB_XGEN(b.x)], 1u);
            asm volatile("s_waitcnt vmcnt(0)" ::: "memory");
        } else {
            XB_SPIN(xb_ld(&bar[XB_XGEN(b.x)]) == gen, bar);
            __builtin_amdgcn_fence(__ATOMIC_ACQUIRE, "agent");
            asm volatile("s_waitcnt vmcnt(0)" ::: "memory");
        }
    }
    __syncthreads();
}

struct Frame {
    LAS unsigned char* lds;
    gu32* ctl;
    int tid, lane, wave, G, bx, dry;
    int wsg;
    const float *x, *c, *ctx, *c_ctx, *w_mod, *b_mod, *norm1_w, *norm2_w, *w_in, *w_out, *hg_lb, *hg_norm_w, *dn_conv_w, *dn_a_log, *dn_dt_bias, *dn_norm_w,
                *w_group, *b_group, *w_expert, *b_expert, *w_gate, *w_up, *w_down, *final_norm_w;
    float* out;
    float *MOD, *LB, *CA, *CH, *BETA, *LOGA, *CUM, *LISTW;
    bf16* XS;
    int* LIST;
    bf16 *WIN, *WOUT, *HBQ, *PHG, *PZ, *PREP, *Wb, *Ub, *QKN, *QKDb;
};

struct TrItem { const float* W; bf16* WT; int ldW, Kp, k0, n0, dst_row0; };
DI void transpose_load(float (&tv)[32], const TrItem& I, int lane) {
#pragma unroll
    for (int i = 0; i < 32; ++i) tv[i] = I.W[(size_t)(I.k0 + 2 * i + (lane >> 5)) * I.ldW + I.n0 + (lane & 31)];
}
DI void transpose_store(const float (&tv)[32], const TrItem& I, LAS float* scr, int lane) {
#pragma unroll
    for (int i = 0; i < 32; ++i) scr[(2 * i + (lane >> 5)) * 33 + (lane & 31)] = tv[i];
    LDS_WAIT(); asm volatile("" ::: "memory");
    const int c = lane & 7;
#pragma unroll
    for (int j = 0; j < 4; ++j) { const int n = (lane >> 3) + 8 * j; const LAS float* s = scr + (8 * c) * 33 + n;
        u32x4 o; o.x = cvt_pk_bf16(s[0 * 33], s[1 * 33]); o.y = cvt_pk_bf16(s[2 * 33], s[3 * 33]); o.z = cvt_pk_bf16(s[4 * 33], s[5 * 33]); o.w = cvt_pk_bf16(s[6 * 33], s[7 * 33]);
        *(u32x4*)(I.WT + (size_t)(I.dst_row0 + n) * I.Kp + I.k0 + 8 * c) = o; }
    LDS_WAIT(); asm volatile("" ::: "memory");
}
#define TRANSPOSE_LOOP(first, N, stride, DEC) do { int it_ = (first); if (it_ < (N)) { float tva_[32], tvb_[32]; TrItem ia_ = DEC(it_), ib_ = ia_; transpose_load(tva_, ia_, F.lane); \
        for (;;) { int nx_ = it_ + (stride); const bool h1_ = nx_ < (N); if (h1_) { ib_ = DEC(nx_); transpose_load(tvb_, ib_, F.lane); } \
            transpose_store(tva_, ia_, scr, F.lane); if (!h1_) break; \
            it_ = nx_ + (stride); const bool h2_ = it_ < (N); if (h2_) { ia_ = DEC(it_); transpose_load(tva_, ia_, F.lane); } \
            transpose_store(tvb_, ib_, scr, F.lane); if (!h2_) break; } } } while (0)

struct Args { const float* in[24]; float* out; unsigned char* ws; int ph_lo, ph_hi, bar_slot; };
typedef const __attribute__((address_space(4))) Args* KArgs;
DI void make_frame(Frame& F) {
    extern __shared__ __attribute__((aligned(16))) unsigned char lds_raw[];
    KArgs ka = (KArgs)__builtin_amdgcn_kernarg_segment_ptr(); asm volatile("" : "+s"(ka));
    int wv_ = F.wsg; asm volatile("" : "+s"(wv_));
    unsigned z_ = 0u; asm volatile("" : "+v"(z_));
    int t = wv_ * 64 + (int)__builtin_amdgcn_mbcnt_hi(~0u, __builtin_amdgcn_mbcnt_lo(~0u, z_)); asm volatile("" : "+v"(t));
    { LAS unsigned char* lb = (LAS unsigned char*)lds_raw; asm volatile("" : "+s"(lb)); F.lds = lb; }
    F.tid = t; F.lane = t & 63; F.wave = wv_;
    { int g = gridDim.x, b = blockIdx.x; asm volatile("" : "+s"(g), "+s"(b)); F.G = g; F.bx = b; }
    F.dry = (ka->ph_hi >> 16) & 3;
    unsigned char* ws = ka->ws;
    F.ctl = (gu32*)(ws + WS_CTL);
    F.x = ka->in[0]; F.c = ka->in[1]; F.ctx = ka->in[2]; F.c_ctx = ka->in[3]; F.w_mod = ka->in[4]; F.b_mod = ka->in[5]; F.norm1_w = ka->in[6]; F.norm2_w = ka->in[7];
    F.w_in = ka->in[8]; F.w_out = ka->in[9]; F.hg_lb = ka->in[10]; F.hg_norm_w = ka->in[11]; F.dn_conv_w = ka->in[12]; F.dn_a_log = ka->in[13]; F.dn_dt_bias = ka->in[14]; F.dn_norm_w = ka->in[15];
    F.w_group = ka->in[16]; F.b_group = ka->in[17]; F.w_expert = ka->in[18]; F.b_expert = ka->in[19]; F.w_gate = ka->in[20]; F.w_up = ka->in[21]; F.w_down = ka->in[22]; F.final_norm_w = ka->in[23];
    F.out = ka->out;
    F.MOD = (float*)(ws + WS_MOD); F.LB = (float*)(ws + WS_LB); F.CA = (float*)(ws + WS_CA); F.CH = (float*)(ws + WS_CH); F.BETA = (float*)(ws + WS_BETA); F.LOGA = (float*)(ws + WS_LOGA); F.CUM = (float*)(ws + WS_CUM); F.LIST = (int*)(ws + WS_LIST); F.LISTW = (float*)(ws + WS_LISTW);
    F.XS = (bf16*)(ws + WS_XS); F.WIN = (bf16*)(ws + WS_WIN); F.WOUT = (bf16*)(ws + WS_WOUT); F.HBQ = (bf16*)(ws + WS_HBQ); F.PHG = (bf16*)(ws + WS_PHG); F.PZ = (bf16*)(ws + WS_PZ); F.PREP = (bf16*)(ws + WS_PREP);
    F.Wb = (bf16*)(ws + WS_XS + XSLOT_W); F.Ub = (bf16*)(ws + WS_PREP + PREP_U); F.QKN = (bf16*)(ws + WS_HBQ); F.QKDb = (bf16*)(ws + WS_QKD);
}
DI void row_info(int t, int& b, int& r, int& modrow) { b = t / RPB; r = t - b * RPB; modrow = (r < CTXL) ? 16 : b; }

DI void load_xrow(const Frame& F, int l, int t, int b, int r, int modrow, f32x4 (&v)[4]) {
    if (l == 0) {
        const float* src = (r < CTXL) ? F.ctx + ((size_t)b * CTXL + r) * D : F.x + ((size_t)b * SEQ + (r - CTXL)) * D;
#pragma unroll
        for (int j = 0; j < 4; ++j) v[j] = ((const f32x4*)src)[F.lane + 64 * j];
    } else {
        const u32x2* xs = (const u32x2*)(F.XS + (size_t)t * D);
        const u32x2* y0 = (const u32x2*)(F.PHG + (size_t)t * D); const u32x2* y1 = (const u32x2*)(F.PHG + ((size_t)T + t) * D);
        const f32x4* g2 = (const f32x4*)(F.MOD + ((size_t)(l - 1) * 17 + modrow) * MODW + 5 * D);
#pragma unroll
        for (int j = 0; j < 4; ++j) { const int e = F.lane + 64 * j; const f32x4 g = g2[e]; const u32x2 xv = xs[e], a = y0[e], c = y1[e];
            f32x4 y; y[0] = bflo(a.x) + bflo(c.x); y[1] = bfhi(a.x) + bfhi(c.x); y[2] = bflo(a.y) + bflo(c.y); y[3] = bfhi(a.y) + bfhi(c.y);
            f32x4 x; x[0] = bflo(xv.x); x[1] = bfhi(xv.x); x[2] = bflo(xv.y); x[3] = bfhi(xv.y);
            v[j] = x + g * y; }
    }
}
struct RowRaw { f32x4 x[4]; u32x2 c[4]; };
DI void row_issue(const Frame& F, int l, int t, RowRaw& R) {
    int b, r, modrow; row_info(t, b, r, modrow);
    if (l == 0) {
        const float* src = (r < CTXL) ? F.ctx + ((size_t)b * CTXL + r) * D : F.x + ((size_t)b * SEQ + (r - CTXL)) * D;
#pragma unroll
        for (int j = 0; j < 4; ++j) R.x[j] = ((const f32x4*)src)[F.lane + 64 * j];
    } else {
        const u32x2* xs = (const u32x2*)(F.XS + (size_t)t * D);
        const u32x2* y0 = (const u32x2*)(F.PHG + (size_t)t * D); const u32x2* y1 = (const u32x2*)(F.PHG + ((size_t)T + t) * D);
#pragma unroll
        for (int j = 0; j < 4; ++j) { const int e = F.lane + 64 * j; const u32x2 xv = xs[e], a = y0[e];
            R.x[j][0] = __uint_as_float(xv.x); R.x[j][1] = __uint_as_float(xv.y); R.x[j][2] = __uint_as_float(a.x); R.x[j][3] = __uint_as_float(a.y); R.c[j] = y1[e]; }
    }
}
DI void row_finish(const Frame& F, int l, int modrow, const RowRaw& R, f32x4 (&v)[4]) {
    if (l == 0) {
#pragma unroll
        for (int j = 0; j < 4; ++j) v[j] = R.x[j];
    } else {
        const f32x4* g2 = (const f32x4*)(F.MOD + ((size_t)(l - 1) * 17 + modrow) * MODW + 5 * D);
#pragma unroll
        for (int j = 0; j < 4; ++j) { const u32x2 c = R.c[j]; const unsigned x0 = __float_as_uint(R.x[j][0]), x1 = __float_as_uint(R.x[j][1]), a0 = __float_as_uint(R.x[j][2]), a1 = __float_as_uint(R.x[j][3]);
            f32x4 y; y[0] = bflo(a0) + bflo(c.x); y[1] = bfhi(a0) + bfhi(c.x); y[2] = bflo(a1) + bflo(c.y); y[3] = bfhi(a1) + bfhi(c.y);
            f32x4 x; x[0] = bflo(x0); x[1] = bfhi(x0); x[2] = bflo(x1); x[3] = bfhi(x1);
            v[j] = x + g2[F.lane + 64 * j] * y; }
    }
}
DI float row_rstd(const f32x4 (&v)[4]) {
    float s = 0.f;
#pragma unroll
    for (int j = 0; j < 4; ++j) s += (v[j][0] * v[j][0] + v[j][1] * v[j][1]) + (v[j][2] * v[j][2] + v[j][3] * v[j][3]);
    return 1.0f / sqrtf(wave_sum(s) * (1.0f / D) + EPS);
}
DI float reduce16(float (&v)[16], int lane) {
#pragma unroll
    for (int i = 0; i < 8; ++i) v[i] = pair32(v[i], v[i + 8]);
#pragma unroll
    for (int i = 0; i < 4; ++i) { const bool hi = (lane & 16) != 0; const float snd = hi ? v[i] : v[i + 4], keep = hi ? v[i + 4] : v[i]; v[i] = keep + swz<16>(snd); }
#pragma unroll
    for (int i = 0; i < 2; ++i) { const bool hi = (lane & 8) != 0; const float snd = hi ? v[i] : v[i + 2], keep = hi ? v[i + 2] : v[i]; v[i] = keep + swz<8>(snd); }
    { const bool hi = (lane & 4) != 0; const float snd = hi ? v[0] : v[1], keep = hi ? v[1] : v[0]; v[0] = keep + swz<4>(snd); }
    v[0] += swz<2>(v[0]); v[0] += swz<1>(v[0]);
    return v[0];
}

DI void phase_prologue(Frame& F) {
    make_frame(F);
    LAS float* sc = (LAS float*)F.lds;
    LAS float* red = (LAS float*)(F.lds + 17 * 1024 * 4);
    for (int i = F.tid; i < 17 * D; i += 512) { const int r = i / D, k = i - r * D; const float cv = (r < 16) ? F.c[r * D + k] : F.c_ctx[k]; sc[i] = silu_f(cv); }
    __syncthreads();
    const int kq = F.tid >> 6, nn = F.tid & 63;
    for (int it = F.bx; it < DEPTH * 96; it += F.G) {
        const int l = it / 96, n0 = (it - l * 96) * 64;
        float acc[17];
#pragma unroll
        for (int r = 0; r < 17; ++r) acc[r] = 0.f;
        const float* wp = F.w_mod + ((size_t)l * D + kq * 128) * MODW + n0 + nn;
#pragma unroll 4
        for (int k = 0; k < 128; ++k) { const float w = wp[(size_t)k * MODW];
#pragma unroll
            for (int r = 0; r < 17; ++r) acc[r] += sc[r * D + kq * 128 + k] * w; }
#pragma unroll
        for (int r = 0; r < 17; ++r) red[(kq * 17 + r) * 64 + nn] = acc[r];
        __syncthreads();
        for (int i = F.tid; i < 17 * 64; i += 512) { const int r = i >> 6, n = i & 63; float s = F.b_mod[l * MODW + n0 + n];
#pragma unroll
            for (int q = 0; q < 8; ++q) s += red[(q * 17 + r) * 64 + n];
            F.MOD[((size_t)l * 17 + r) * MODW + n0 + n] = s; }
        __syncthreads();
    }
    if (F.bx == 0) {
        for (int i = F.tid; i < 2 * 512; i += 512) {
            float xv[DEPTH], m = -1e30f;
#pragma unroll
            for (int l = 0; l < DEPTH; ++l) { xv[l] = F.hg_lb[l * 1024 + i]; m = fmaxf(m, xv[l]); }
            float s = 0.f;
#pragma unroll
            for (int l = 0; l < DEPTH; ++l) { xv[l] = expf(xv[l] - m); s += xv[l]; }
            float cum = 0.f, c0 = 0.f;
#pragma unroll
            for (int l = 0; l < DEPTH; ++l) { cum += xv[l] / s; if (l == 0) c0 = cum; F.LB[l * 1024 + i] = cum - c0; }
        }
    }
}

constexpr int HW_WTS = 2064;
constexpr int AW_WT = 0, AW_WSC = 32 * HW_WTS, AW_SH = AW_WSC + 2 * 1024 * 4, AW_G2 = AW_SH + 2 * 1024 * 4, AW_LGP = AW_G2 + 2 * 1024 * 4, AW_SSP = AW_LGP + 8 * 16 * 17 * 4;
DI void phase_consts(Frame& F) {
    make_frame(F);
    const int gw = F.bx * 8 + F.wave, NGW = F.G * 8;
    for (int task = gw; task < DEPTH * 17; task += NGW) {
        const int l = task / 17, m = task - l * 17;
        const float* sh1 = F.MOD + ((size_t)l * 17 + m) * MODW; const float* sh2 = sh1 + 3 * D;
        float ca[16], ce[16], cg[4];
#pragma unroll
        for (int q = 0; q < 16; ++q) { ca[q] = 0.f; ce[q] = 0.f; }
#pragma unroll
        for (int q = 0; q < 4; ++q) cg[q] = 0.f;
        for (int kk = 0; kk < 16; ++kk) { const int k = F.lane * 16 + kk; const float s1 = sh1[k], s2 = sh2[k];
            const f32x4* wa = (const f32x4*)(F.w_in + ((size_t)l * D + k) * INC + NP); const f32x4* we = (const f32x4*)(F.w_expert + ((size_t)l * D + k) * 16); const f32x4 wg = *(const f32x4*)(F.w_group + ((size_t)l * D + k) * 4);
#pragma unroll
            for (int q4 = 0; q4 < 4; ++q4) { const f32x4 a = wa[q4], e = we[q4];
#pragma unroll
                for (int j = 0; j < 4; ++j) { ca[4 * q4 + j] += s1 * a[j]; ce[4 * q4 + j] += s2 * e[j]; } }
#pragma unroll
            for (int j = 0; j < 4; ++j) cg[j] += s2 * wg[j]; }
#pragma unroll
        for (int q = 0; q < 16; ++q) { const float a = wave_sum(ca[q]), e = wave_sum(ce[q]); if (F.lane == 0) { F.CA[(l * 17 + m) * 16 + q] = a; F.CH[(l * 17 + m) * 20 + 4 + q] = e + F.b_expert[l * 16 + q]; } }
#pragma unroll
        for (int q = 0; q < 4; ++q) { const float gq = wave_sum(cg[q]); if (F.lane == 0) F.CH[(l * 17 + m) * 20 + q] = gq + F.b_group[l * 4 + q]; }
    }
}

constexpr size_t XO_WGU = 0, XO_WDN = 32 * MiB, XO_WOUT1 = 48 * MiB;
DI bf16* wout_buf(const Frame& F, int l) { return (l & 1) ? (bf16*)((char*)F.out + XO_WOUT1) : F.WOUT; }
DI void inout_weight_transposes(Frame& F, int l, int rank, int nblk) {
    LAS float* scr = (LAS float*)(F.lds + F.wave * 8448);
    const float* win = F.w_in + (size_t)l * D * INC; const float* wout = F.w_out + (size_t)l * D * D;
    bf16* WO = wout_buf(F, l);
    constexpr int I_IN = 16 * (NP / 32), I_OUT = 16 * (D / 32);
    auto dec = [&](int it) -> TrItem {
        if (it < I_IN) { const int nblk_ = NP / 32, kb = it / nblk_, nb = it - kb * nblk_; return TrItem{win, F.WIN, INC, D, 64 * kb, 32 * nb, 32 * nb}; }
        const int r = it - I_IN, nblk_ = D / 32, kb = r / nblk_, nb = r - kb * nblk_; return TrItem{wout, WO, D, D, 64 * kb, 32 * nb, 32 * nb}; };
    TRANSPOSE_LOOP(rank * 8 + F.wave, I_IN + I_OUT, nblk * 8, dec);
}

DI void phase_A(Frame& F, int l) {
    make_frame(F);
    const int gw = F.bx * 8 + F.wave, NGW = F.G * 8;
    if (l == 0) inout_weight_transposes(F, 0, F.bx, F.G);
    __syncthreads();
    LAS unsigned char* L = F.lds;
    for (int k = F.tid; k < D; k += 512) {
        const f32x4* wa = (const f32x4*)(F.w_in + ((size_t)l * D + k) * INC + NP);
#pragma unroll
        for (int q4 = 0; q4 < 4; ++q4) { const f32x4 e4 = wa[q4];
#pragma unroll
            for (int j = 0; j < 4; ++j) { const unsigned hi = cvtpk(e4[j], 0.f) & 0xffffu; const unsigned lo = cvtpk(e4[j] - __uint_as_float(hi << 16), 0.f) & 0xffffu;
                *(LAS bf16*)(L + AW_WT + (4 * q4 + j) * HW_WTS + k * 2) = (bf16)hi; *(LAS bf16*)(L + AW_WT + (16 + 4 * q4 + j) * HW_WTS + k * 2) = (bf16)lo; } }
    }
    constexpr int RPWA = T / 2048;
    const int bblk = (F.bx * 8 * RPWA) / RPB;
    const float* n1 = F.norm1_w + l * D;
    for (int i = F.tid; i < 2 * D; i += 512) { const int cls = i >> 10, k = i & 1023; const int mr = cls ? 16 : bblk; const float* md = F.MOD + ((size_t)l * 17 + mr) * MODW;
        *(LAS float*)(L + AW_WSC + i * 4) = n1[k] * (md[D + k] + 1.0f); *(LAS float*)(L + AW_SH + i * 4) = md[k];
        *(LAS float*)(L + AW_G2 + i * 4) = l > 0 ? F.MOD[((size_t)(l - 1) * 17 + mr) * MODW + 5 * D + k] : 0.f; }
    __syncthreads();
    static_assert(RPWA == 18, "phase A row split");
    const int tbeg = gw * RPWA;
#define A_LD(dst, gq) do { _Pragma("unroll") for (int q_ = 0; q_ < 4; ++q_) { const int ks = 4 * (gq) + q_; \
            if (l > 0) { dst[q_][0] = *(const u32x4*)(xsr + 32 * ks); dst[q_][1] = *(const u32x4*)(y0r + 32 * ks); dst[q_][2] = *(const u32x4*)(y1r + 32 * ks); } \
            else { dst[q_][1] = *(const u32x4*)(xf + 32 * ks); dst[q_][2] = *(const u32x4*)(xf + 32 * ks + 4); } } } while (0)
#define A_PROC(src, gq) do { _Pragma("unroll") for (int q_ = 0; q_ < 4; ++q_) { const int ks = 4 * (gq) + q_; float v_[8]; \
            if (l == 0) { const u32x4 xa_ = src[q_][1], xb_ = src[q_][2]; v_[0] = __uint_as_float(xa_.x); v_[1] = __uint_as_float(xa_.y); v_[2] = __uint_as_float(xa_.z); v_[3] = __uint_as_float(xa_.w); \
                v_[4] = __uint_as_float(xb_.x); v_[5] = __uint_as_float(xb_.y); v_[6] = __uint_as_float(xb_.z); v_[7] = __uint_as_float(xb_.w); } \
            else { const u32x4 x = src[q_][0]; v_[0] = bflo(x.x); v_[1] = bfhi(x.x); v_[2] = bflo(x.y); v_[3] = bfhi(x.y); v_[4] = bflo(x.z); v_[5] = bfhi(x.z); v_[6] = bflo(x.w); v_[7] = bfhi(x.w); } \
            if (l > 0) { const u32x4 ya = src[q_][1], yc = src[q_][2]; const f32x4 ga = *(const LAS f32x4*)(g2p + ks * 128), gb = *(const LAS f32x4*)(g2p + ks * 128 + 16); \
                v_[0] += ga[0] * (bflo(ya.x) + bflo(yc.x)); v_[1] += ga[1] * (bfhi(ya.x) + bfhi(yc.x)); v_[2] += ga[2] * (bflo(ya.y) + bflo(yc.y)); v_[3] += ga[3] * (bfhi(ya.y) + bfhi(yc.y)); \
                v_[4] += gb[0] * (bflo(ya.z) + bflo(yc.z)); v_[5] += gb[1] * (bfhi(ya.z) + bfhi(yc.z)); v_[6] += gb[2] * (bflo(ya.w) + bflo(yc.w)); v_[7] += gb[3] * (bfhi(ya.w) + bfhi(yc.w)); } \
            u32x4 xo; xo.x = cvtpk(v_[0], v_[1]); xo.y = cvtpk(v_[2], v_[3]); xo.z = cvtpk(v_[4], v_[5]); xo.w = cvtpk(v_[6], v_[7]); if (st) *(u32x4*)(xsw + 32 * ks) = xo; if (KEEP) src[q_][0] = xo; \
            _Pragma("unroll") for (int j_ = 0; j_ < 8; ++j_) ss8[j_] += v_[j_] * v_[j_]; \
            asm volatile("" : "+v"(ss8[0]), "+v"(ss8[1]), "+v"(ss8[2]), "+v"(ss8[3]), "+v"(ss8[4]), "+v"(ss8[5]), "+v"(ss8[6]), "+v"(ss8[7]));     \
            const f32x4 w0 = *(const LAS f32x4*)(wscp + ks * 128), w1 = *(const LAS f32x4*)(wscp + ks * 128 + 16); \
            const float h0 = v_[0] * w0[0], h1 = v_[1] * w0[1], h2 = v_[2] * w0[2], h3 = v_[3] * w0[3], h4 = v_[4] * w1[0], h5 = v_[5] * w1[1], h6 = v_[6] * w1[2], h7 = v_[7] * w1[3]; \
            u32x4 ah; ah.x = cvtpk(h0, h1); ah.y = cvtpk(h2, h3); ah.z = cvtpk(h4, h5); ah.w = cvtpk(h6, h7); \
            const bf16x8 Ah = __builtin_bit_cast(bf16x8, ah); \
            const bf16x8 Al = pack8(h0 - bflo(ah.x), h1 - bfhi(ah.x), h2 - bflo(ah.y), h3 - bfhi(ah.y), h4 - bflo(ah.z), h5 - bfhi(ah.z), h6 - bflo(ah.w), h7 - bfhi(ah.w)); \
            const bf16x8 B0 = *(const LAS bf16x8*)(b0p + ks * 64), B1 = *(const LAS bf16x8*)(b1p + ks * 64); \
            acc = MFMA16(Ah, B0, acc); acc = MFMA16(Al, B0, acc); acc = MFMA16(Ah, B1, acc); } } while (0)
#define A_LD2(dst, gq) do { _Pragma("unroll") for (int q_ = 0; q_ < 4; ++q_) dst[q_][0] = *(const u32x4*)(xsr + 32 * (4 * (gq) + q_)); } while (0)
#define A_OUT(src, gq) do { _Pragma("unroll") for (int q_ = 0; q_ < 4; ++q_) { const int ks = 4 * (gq) + q_; \
            const u32x4 x = src[q_][0]; const f32x4 w0 = *(const LAS f32x4*)(wscp + ks * 128), w1 = *(const LAS f32x4*)(wscp + ks * 128 + 16), s0 = *(const LAS f32x4*)(shp + ks * 128), s1 = *(const LAS f32x4*)(shp + ks * 128 + 16); \
            u32x4 o; o.x = cvtpk(bflo(x.x) * w0[0] * rstd + s0[0], bfhi(x.x) * w0[1] * rstd + s0[1]); o.y = cvtpk(bflo(x.y) * w0[2] * rstd + s0[2], bfhi(x.y) * w0[3] * rstd + s0[3]); \
            o.z = cvtpk(bflo(x.z) * w1[0] * rstd + s1[0], bfhi(x.z) * w1[1] * rstd + s1[1]); o.w = cvtpk(bflo(x.w) * w1[2] * rstd + s1[2], bfhi(x.w) * w1[3] * rstd + s1[3]); \
            *(u32x4*)(ho + 32 * ks) = o; } } while (0)
#define A_THIN(accv, TROW) do { const int dir = (c >> 2) & 1, hh = c & 3; \
            const float alog = -__expf(F.dn_a_log[(l * 2 + dir) * 4 + hh]), dtb = F.dn_dt_bias[(l * 2 + dir) * 4 + hh]; \
            _Pragma("unroll") for (int j = 0; j < 4; ++j) { const int row = 4 * g + j; const float rs = lane_get(rstd, row); \
                const int t2 = TROW(row); int b2, r2, m2; row_info(t2, b2, r2, m2); \
                const float val = accv[j] * rs + F.CA[(l * 17 + m2) * 16 + c]; \
                if (c < 8) F.BETA[((size_t)dir * T + t2) * 4 + hh] = sigmoid_f(val); else F.LOGA[((size_t)dir * T + t2) * 4 + hh] = alog * softplus_f(val + dtb); } } while (0)
#define SBA() __builtin_amdgcn_sched_barrier(0)
    {
        constexpr bool KEEP = false;
        int c_o = F.lane & 15, g_o = F.lane >> 4; asm volatile("" : "+v"(c_o), "+v"(g_o)); const int c = c_o, g = g_o;
        const int t = tbeg + c;
        int b, r, modrow; row_info(t, b, r, modrow); const int cls = modrow == 16 ? 1 : 0;
        const bf16* xsr = F.XS + (size_t)t * D + 8 * g; const bf16* y0r = F.PHG + (size_t)t * D + 8 * g; const bf16* y1r = F.PHG + ((size_t)T + t) * D + 8 * g;
        bf16* xsw = F.XS + (size_t)t * D + 8 * g; bf16* ho = F.HBQ + (size_t)t * D + 8 * g;
        const float* xf = (r < CTXL ? F.ctx + ((size_t)b * CTXL + r) * D : F.x + ((size_t)b * SEQ + (r - CTXL)) * D) + 8 * g;
        const LAS unsigned char* wscp = L + AW_WSC + (cls * D + 8 * g) * 4; const LAS unsigned char* shp = L + AW_SH + (cls * D + 8 * g) * 4; const LAS unsigned char* g2p = L + AW_G2 + (cls * D + 8 * g) * 4;
        const LAS unsigned char* b0p = L + AW_WT + c * HW_WTS + 8 * g * 2; const LAS unsigned char* b1p = b0p + 16 * HW_WTS;
        f32x4 acc = {0.f, 0.f, 0.f, 0.f}; float ss8[8] = {0.f, 0.f, 0.f, 0.f, 0.f, 0.f, 0.f, 0.f};
        const bool st = !F.dry;
        u32x4 ra[4][3], rb[4][3];
        A_LD(ra, 0); SBA();
        A_LD(rb, 1); SBA(); A_PROC(ra, 0); SBA();
        A_LD(ra, 2); SBA(); A_PROC(rb, 1); SBA();
        A_LD(rb, 3); SBA(); A_PROC(ra, 2); SBA();
        A_LD(ra, 4); SBA(); A_PROC(rb, 3); SBA();
        A_LD(rb, 5); SBA(); A_PROC(ra, 4); SBA();
        A_LD(ra, 6); SBA(); A_PROC(rb, 5); SBA();
        A_LD(rb, 7); SBA(); A_PROC(ra, 6); SBA();
        A_PROC(rb, 7); SBA();
        float ss = ((ss8[0] + ss8[1]) + (ss8[2] + ss8[3])) + ((ss8[4] + ss8[5]) + (ss8[6] + ss8[7])); ss += swz<16>(ss); ss = add_x32(ss);
        const float rstd = 1.0f / sqrtf(ss * (1.0f / D) + EPS);
#define A_TROW1(row) (tbeg + (row))
        A_THIN(acc, A_TROW1);
#undef A_TROW1
        asm volatile("s_waitcnt vmcnt(0)" ::: "memory");
        A_LD2(ra, 0); A_LD2(rb, 1); SBA(); A_OUT(ra, 0); SBA();
        A_LD2(ra, 2); SBA(); A_OUT(rb, 1); SBA();
        A_LD2(rb, 3); SBA(); A_OUT(ra, 2); SBA();
        A_LD2(ra, 4); SBA(); A_OUT(rb, 3); SBA();
        A_LD2(rb, 5); SBA(); A_OUT(ra, 4); SBA();
        A_LD2(ra, 6); SBA(); A_OUT(rb, 5); SBA();
        A_LD2(rb, 7); SBA(); A_OUT(ra, 6); SBA();
        A_OUT(rb, 7);
    }
    {
        constexpr bool KEEP = true;
        int c_o = F.lane & 15, g_o = F.lane >> 4; asm volatile("" : "+v"(c_o), "+v"(g_o)); const int c = c_o, g = g_o;
        const int w = F.wave;
#define A_TROW2(row) ((F.bx * 8 + ((row) >> 1)) * RPWA + 16 + ((row) & 1))
        const int t = A_TROW2(c);
        int b, r, modrow; row_info(t, b, r, modrow); const int cls = modrow == 16 ? 1 : 0;
        const int ko = 128 * w + 8 * g;
        const bf16* xsr = F.XS + (size_t)t * D + ko; const bf16* y0r = F.PHG + (size_t)t * D + ko; const bf16* y1r = F.PHG + ((size_t)T + t) * D + ko;
        bf16* xsw = F.XS + (size_t)t * D + ko; bf16* ho = F.HBQ + (size_t)t * D + ko;
        const float* xf = (r < CTXL ? F.ctx + ((size_t)b * CTXL + r) * D : F.x + ((size_t)b * SEQ + (r - CTXL)) * D) + ko;
        const LAS unsigned char* wscp = L + AW_WSC + (cls * D + ko) * 4; const LAS unsigned char* shp = L + AW_SH + (cls * D + ko) * 4; const LAS unsigned char* g2p = L + AW_G2 + (cls * D + ko) * 4;
        const LAS unsigned char* b0p = L + AW_WT + c * HW_WTS + ko * 2; const LAS unsigned char* b1p = b0p + 16 * HW_WTS;
        f32x4 acc = {0.f, 0.f, 0.f, 0.f}; float ss8[8] = {0.f, 0.f, 0.f, 0.f, 0.f, 0.f, 0.f, 0.f};
        const bool st = !F.dry;
        u32x4 ra[4][3];
        A_LD(ra, 0); SBA(); A_PROC(ra, 0); SBA();
        float ss = ((ss8[0] + ss8[1]) + (ss8[2] + ss8[3])) + ((ss8[4] + ss8[5]) + (ss8[6] + ss8[7])); ss += swz<16>(ss); ss = add_x32(ss);
        LAS float* LGP = (LAS float*)(L + AW_LGP); LAS float* SSP = (LAS float*)(L + AW_SSP);
#pragma unroll
        for (int j = 0; j < 4; ++j) LGP[w * 16 * 17 + (4 * g + j) * 17 + c] = acc[j];
        if (g == 0) SSP[w * 16 + c] = ss;
        __syncthreads();
        float sst = 0.f;
#pragma unroll
        for (int w2 = 0; w2 < 8; ++w2) sst += SSP[w2 * 16 + c];
        const float rstd = 1.0f / sqrtf(sst * (1.0f / D) + EPS);
        A_OUT(ra, 0);
        if (w == 0) {
            f32x4 at = {0.f, 0.f, 0.f, 0.f};
#pragma unroll
            for (int w2 = 0; w2 < 8; ++w2)
#pragma unroll
                for (int j = 0; j < 4; ++j) at[j] += LGP[w2 * 16 * 17 + (4 * g + j) * 17 + c];
            A_THIN(at, A_TROW2);
        }
#undef A_TROW2
    }
#undef A_LD
#undef A_PROC
#undef A_LD2
#undef A_OUT
#undef A_THIN
#undef SBA
}

DI int step_row(int dir, int i) { return dir == 0 ? i : (i < CTXL ? CTXL - 1 - i : (RPB + CTXL - 1) - i); }

constexpr int RS = 272;
constexpr int HIMG = 32 * RS;
constexpr int H_RAWQ = 0, H_RAWF = 2 * HIMG, H_V = 4 * HIMG, H_QT = 6 * HIMG, H_KB = 8 * HIMG, H_KT = 10 * HIMG, H_OST = 12 * HIMG, H_G = 14 * HIMG;
static_assert(H_G + 1024 <= RING_BYTES, "HGRN2 LDS map");
DI void hg_unit(Frame& F, int unit) {
    make_frame(F);
    const int b = unit >> 3, h = (unit >> 1) & 3, dir = unit & 1;
    LAS unsigned char* L = F.lds;
    const int lane = F.lane, w = F.wave, c = lane & 15, g = lane >> 4, q4 = (lane & 15) >> 2, p = lane & 3;
    const int srow = F.tid >> 4, c8 = (F.tid & 15) * 8;
    const int d0 = 16 * w, e0 = 16 * w;
    bf16* Pb = F.PHG + phg_idx(b, h, 0);
    bf16x8 LT[2];
#pragma unroll
    for (int nt = 0; nt < 2; ++nt)
#pragma unroll
        for (int j = 0; j < 8; ++j) LT[nt][j] = (8 * g + j <= c + 16 * nt) ? (short)0x3F80 : (short)0;
    f32x4 S[8];
#pragma unroll
    for (int dt = 0; dt < 8; ++dt) S[dt] = (f32x4){0.f, 0.f, 0.f, 0.f};
    constexpr int NCH = RPB / 32;
    struct HgRegs { u32x4 rq, rf, rv; }; HgRegs RG[2];
#define HG_LOAD(n, R) do { const bf16* pr_ = Pb + (size_t)step_row(dir, (n) * 32 + srow) * 512 + c8; R.rq = *(const u32x4*)pr_; R.rv = *(const u32x4*)(pr_ + 128); R.rf = *(const u32x4*)(pr_ + 256 + dir * 128); } while (0)
#define HG_WRITE_RAW(n, R) do { const int o_ = ((n) & 1) * HIMG + srow * RS + c8 * 2; *(LAS u32x4*)(L + H_RAWQ + o_) = R.rq; *(LAS u32x4*)(L + H_RAWF + o_) = R.rf; } while (0)
#define HG_WRITE_V(n, R) do { *(LAS u32x4*)(L + H_V + ((n) & 1) * HIMG + srow * RS + c8 * 2) = R.rv; } while (0)
#define HG_PREP(n) do { const int bi_ = (n) & 1; \
        const bf16x8 af_ = cat8(ds_tr(L + H_RAWF + bi_ * HIMG + (8 * g + q4) * RS + (d0 + 4 * p) * 2), ds_tr(L + H_RAWF + bi_ * HIMG + (8 * g + 4 + q4) * RS + (d0 + 4 * p) * 2)); \
        f32x4 cu_[2]; cu_[0] = MFMA16(af_, LT[0], ((f32x4){0.f, 0.f, 0.f, 0.f})); cu_[1] = MFMA16(af_, LT[1], ((f32x4){0.f, 0.f, 0.f, 0.f})); \
        float cl_[4]; _Pragma("unroll") for (int jj = 0; jj < 4; ++jj) cl_[jj] = lane_get(cu_[1][jj], (lane & 48) | 15); \
        _Pragma("unroll") for (int nt = 0; nt < 2; ++nt) { const int t_ = c + 16 * nt, o_ = t_ * RS + (d0 + 4 * g) * 2, op_ = t_ * RS + (32 * (w >> 1) + 8 * g + 4 * (w & 1)) * 2; \
            const u32x2 qq_ = *(const LAS u32x2*)(L + H_RAWQ + bi_ * HIMG + o_), ff_ = *(const LAS u32x2*)(L + H_RAWF + bi_ * HIMG + o_); \
            const float qv_[4] = {bflo(qq_.x), bfhi(qq_.x), bflo(qq_.y), bfhi(qq_.y)}, lf_[4] = {bflo(ff_.x), bfhi(ff_.x), bflo(ff_.y), bfhi(ff_.y)}; \
            float qt_[4], kb_[4], kt_[4]; \
            _Pragma("unroll") for (int jj = 0; jj < 4; ++jj) { const float cu = cu_[nt][jj], kk = 1.0f - __expf(lf_[jj]); \
                qt_[jj] = qv_[jj] * __expf(cu); kb_[jj] = kk * __expf(fminf(-cu, 80.0f)); kt_[jj] = kk * __expf(cl_[jj] - cu); } \
            u32x2 w_; w_.x = cvtpk(qt_[0], qt_[1]); w_.y = cvtpk(qt_[2], qt_[3]); *(LAS u32x2*)(L + H_QT + bi_ * HIMG + op_) = w_; \
            w_.x = cvtpk(kb_[0], kb_[1]); w_.y = cvtpk(kb_[2], kb_[3]); *(LAS u32x2*)(L + H_KB + bi_ * HIMG + op_) = w_; \
            w_.x = cvtpk(kt_[0], kt_[1]); w_.y = cvtpk(kt_[2], kt_[3]); *(LAS u32x2*)(L + H_KT + bi_ * HIMG + o_) = w_; } \
        if (c == 0) *(LAS f32x4*)(L + H_G + bi_ * 512 + (d0 + 4 * g) * 4) = (f32x4){__expf(cl_[0]), __expf(cl_[1]), __expf(cl_[2]), __expf(cl_[3])}; \
    } while (0)
    static_assert(NCH % 2 == 0, "chunk pairs");
#define HG_STORE_O(m) do { const u32x4 ov_ = *(const LAS u32x4*)(L + H_OST + ((m) & 1) * HIMG + srow * RS + c8 * 2); \
        if (!F.dry) *(u32x4*)(Pb + (size_t)step_row(dir, (m) * 32 + srow) * 512 + 256 + dir * 128 + c8) = ov_; } while (0)
    HG_LOAD(0, RG[0]); HG_LOAD(1, RG[1]); HG_WRITE_RAW(0, RG[0]); HG_WRITE_V(0, RG[0]); HG_LOAD(2, RG[0]);
    __syncthreads();
    HG_PREP(0);
    for (int n2 = 0; n2 < NCH; n2 += 2) {
#pragma unroll
      for (int hh = 0; hh < 2; ++hh) {
        const int n = n2 + hh;
        const int bi = hh;
        if (n + 1 < NCH) HG_WRITE_RAW(n + 1, RG[1 - hh]);
        __syncthreads();
        if (n + 1 < NCH) { HG_WRITE_V(n + 1, RG[1 - hh]); if (n + 3 < NCH) HG_LOAD(n + 3, RG[1 - hh]); }
        if (n > 0) HG_STORE_O(n - 1);
        __builtin_amdgcn_sched_barrier(0);
        if (n + 1 < NCH) HG_PREP(n + 1);
        __builtin_amdgcn_sched_barrier(0);
        {
#define SB() __builtin_amdgcn_sched_barrier(0)
            const LAS unsigned char* Vb = L + H_V + bi * HIMG; const LAS unsigned char* QTb = L + H_QT + bi * HIMG; const LAS unsigned char* KBb = L + H_KB + bi * HIMG; const LAS unsigned char* KTb = L + H_KT + bi * HIMG;
            bf16x8 ka0[4], ka1[4], qb0[4], qb1[4];
#pragma unroll
            for (int ks = 0; ks < 4; ++ks) { const int co = (32 * ks + 8 * g) * 2;
                ka0[ks] = *(const LAS bf16x8*)(KBb + c * RS + co); ka1[ks] = *(const LAS bf16x8*)(KBb + (c + 16) * RS + co);
                qb0[ks] = *(const LAS bf16x8*)(QTb + c * RS + co); qb1[ks] = *(const LAS bf16x8*)(QTb + (c + 16) * RS + co); }
            const bf16x8 bv = cat8(ds_tr(Vb + (4 * g + q4) * RS + (e0 + 4 * p) * 2), ds_tr(Vb + (16 + 4 * g + q4) * RS + (e0 + 4 * p) * 2));
            SB();
            f32x4 at00 = {0.f, 0.f, 0.f, 0.f}, at01 = at00, at11 = at00;
#pragma unroll
            for (int ks = 0; ks < 4; ++ks) { at00 = MFMA16(ka0[ks], qb0[ks], at00); at01 = MFMA16(ka0[ks], qb1[ks], at01); at11 = MFMA16(ka1[ks], qb1[ks], at11); }
            f32x4 o0 = {0.f, 0.f, 0.f, 0.f}, o1 = o0;
#pragma unroll
            for (int ks = 0; ks < 4; ++ks) {
                const bf16x8 Bs = pack8(S[2 * ks][0], S[2 * ks][1], S[2 * ks][2], S[2 * ks][3], S[2 * ks + 1][0], S[2 * ks + 1][1], S[2 * ks + 1][2], S[2 * ks + 1][3]);
                o0 = MFMA16(qb0[ks], Bs, o0); o1 = MFMA16(qb1[ks], Bs, o1);
            }
            SB();
            bf16x8 Ak[8]; f32x4 gv[8];
#pragma unroll
            for (int dt = 0; dt < 8; ++dt) { gv[dt] = *(const LAS f32x4*)(L + H_G + bi * 512 + (16 * dt + 4 * g) * 4);
                Ak[dt] = cat8(ds_tr(KTb + (4 * g + q4) * RS + (16 * dt + 4 * p) * 2), ds_tr(KTb + (16 + 4 * g + q4) * RS + (16 * dt + 4 * p) * 2)); }
            SB();
#pragma unroll
            for (int jj = 0; jj < 4; ++jj) { const bool keep = (4 * g + jj <= c); at00[jj] = keep ? at00[jj] : 0.f; at11[jj] = keep ? at11[jj] : 0.f; }
            const bf16x8 A0 = pack8(at00[0], at00[1], at00[2], at00[3], 0.f, 0.f, 0.f, 0.f), A1 = pack8(at01[0], at01[1], at01[2], at01[3], at11[0], at11[1], at11[2], at11[3]);
            o0 = MFMA16(A0, bv, o0); o1 = MFMA16(A1, bv, o1);
#pragma unroll
            for (int dt = 0; dt < 8; ++dt) S[dt] = MFMA16(Ak[dt], bv, S[dt] * gv[dt]);
            SB();
#pragma unroll
            for (int jj = 0; jj < 4; ++jj) { *(LAS bf16*)(L + H_OST + bi * HIMG + (4 * g + jj) * RS + (e0 + c) * 2) = (bf16)(cvtpk(o0[jj], 0.f) & 0xffffu); *(LAS bf16*)(L + H_OST + bi * HIMG + (16 + 4 * g + jj) * RS + (e0 + c) * 2) = (bf16)(cvtpk(o1[jj], 0.f) & 0xffffu); }
#undef SB
        }
      }
    }
    __syncthreads();
    HG_STORE_O(NCH - 1);
    __syncthreads();
#undef HG_STORE_O
#undef HG_WRITE_V
#undef HG_LOAD
#undef HG_WRITE_RAW
#undef HG_PREP
}


constexpr int D_Q = 0, D_K = 64 * RS, D_V = 2 * 64 * RS, D_NB = 3 * 64 * RS, D_ND = D_NB + 2 * 64 * 144, D_T = D_ND + 2 * 4 * 16 * 17 * 4, D_SC = D_T + 2 * 64 * 48, D_CW = D_SC + 2 * 768, D_DUM = D_CW + 9 * 1536 * 2;
constexpr int NRS = 144, TRS = 48;
static_assert(D_DUM + 256 <= RING_BYTES, "phase D LDS map");
DI void phase_D(Frame& F, int l) {
    make_frame(F);
    LAS unsigned char* L = F.lds;
    const int lane = F.lane, w = F.wave, c = lane & 15, g = lane >> 4;
    const int dir = w >> 2, wq = w & 3;
    const bf16* RAW = F.PREP + PREP_RAW / 2;
    bf16* Wg = F.Wb; bf16* QKDg = F.QKDb;
    LAS float* SC = (LAS float*)(L + D_SC + dir * 768);
    LAS float* ND = (LAS float*)(L + D_ND + dir * 4352);
    LAS unsigned char* NBi = L + D_NB + dir * 9216; LAS unsigned char* Ti = L + D_T + dir * 3072;
    { const float* cw = F.dn_conv_w + (size_t)l * 9 * 1536;
      for (int i = F.tid; i < 9 * 1536 / 4; i += 512) { const f32x4 v = ((const f32x4*)cw)[i]; u32x2 o; o.x = cvtpk(v[0], v[1]); o.y = cvtpk(v[2], v[3]); *(LAS u32x2*)(L + D_CW + i * 8) = o; } }
    __syncthreads();
#define D_UNIT(u_) ((F.G == 256) ? (((F.bx & 7) + 8 * ((((u_) >> 8) * 32 + (F.bx >> 3)) / 36)) * 36 + ((((u_) >> 8) * 32 + (F.bx >> 3)) % 36)) : (u_))
    if (F.dry != 2) {
        const int s4 = F.lane >> 4, c8 = (F.lane & 15) * 8;
        const int nun = (NB * 4 * 36 - F.bx + F.G - 1) / F.G;
#define DC_ISSUE(task_, dst, DY0, DY1) do { const int ui_ = (task_) / 12, r12_ = (task_) - 12 * ui_, q_ = r12_ >> 2, t0_ = 16 * (r12_ & 3) + 4 * s4; \
            const int u_ = D_UNIT(F.bx + ui_ * F.G), b_ = u_ / 144, rem_ = u_ - b_ * 144, h_ = rem_ / 36, ck_ = rem_ - h_ * 36; const bool ic_ = ck_ < 4; \
            const char* ub_ = (const char*)(F.PREP + PREP_RAW / 2 + (size_t)b_ * RPB * 1536 + q_ * 512 + h_ * 128); \
            _Pragma("unroll") for (int dy = DY0; dy < DY1; ++dy) _Pragma("unroll") for (int i = 0; i < 6; ++i) { const int xx = t0_ + i - 1, yy = ck_ - 4 + dy - 1; \
                const bool ok = ic_ ? (dy == 1 && 64 * ck_ + xx >= 0 && 64 * ck_ + xx < CTXL) : (yy >= 0 && yy < 32 && xx >= 0 && xx < 64); \
                const unsigned off_ = ok ? (unsigned)((ic_ ? (64 * ck_ + xx) : (CTXL + yy * 64 + xx)) * 1536 + c8) * 2u : (unsigned)c8 * 2u; \
                const u32x4 ld_ = *(const u32x4*)(ub_ + off_); const unsigned m_ = ok ? 0xffffffffu : 0u; dst[dy][i] = (u32x4){ld_.x & m_, ld_.y & m_, ld_.z & m_, ld_.w & m_}; } } while (0)
        u32x4 xv[3][6], xn[2][6];
        if (F.wave < 12 * nun) DC_ISSUE(F.wave, xv, 0, 2);
        for (int task = F.wave; task < 12 * nun; task += 8) {
            const int ui = task / 12, r12 = task - 12 * ui, q = r12 >> 2, t0 = 16 * (r12 & 3) + 4 * s4;
            const int u = D_UNIT(F.bx + ui * F.G), b = u / 144, rem = u - b * 144, h = rem / 36, ck = rem - h * 36;
            DC_ISSUE(task, xv, 2, 3);
            if (task + 8 < 12 * nun) DC_ISSUE(task + 8, xn, 0, 2);
            __builtin_amdgcn_sched_barrier(0);
            float acc[4][8];
#pragma unroll
            for (int o = 0; o < 4; ++o)
#pragma unroll
                for (int j = 0; j < 8; ++j) acc[o][j] = 0.f;
#pragma unroll
            for (int dy = 0; dy < 3; ++dy)
#pragma unroll
                for (int dx = 0; dx < 3; ++dx) { const u32x4 w_ = *(const LAS u32x4*)(L + D_CW + ((dy * 3 + dx) * 1536 + q * 512 + h * 128 + c8) * 2);
                    const float wf[8] = {bflo(w_.x), bfhi(w_.x), bflo(w_.y), bfhi(w_.y), bflo(w_.z), bfhi(w_.z), bflo(w_.w), bfhi(w_.w)};
#pragma unroll
                    for (int o = 0; o < 4; ++o) { const u32x4 x = xv[dy][o + dx];
                        acc[o][0] += bflo(x.x) * wf[0]; acc[o][1] += bfhi(x.x) * wf[1]; acc[o][2] += bflo(x.y) * wf[2]; acc[o][3] += bfhi(x.y) * wf[3];
                        acc[o][4] += bflo(x.z) * wf[4]; acc[o][5] += bfhi(x.z) * wf[5]; acc[o][6] += bflo(x.w) * wf[6]; acc[o][7] += bfhi(x.w) * wf[7]; } }
#pragma unroll
            for (int o = 0; o < 4; ++o) {
                float ss = 0.f;
#pragma unroll
                for (int j = 0; j < 8; ++j) { acc[o][j] = silu_f(acc[o][j]); ss += acc[o][j] * acc[o][j]; }
                if (q < 2) { ss += swz<1>(ss); ss += swz<2>(ss); ss += swz<4>(ss); ss += swz<8>(ss);
                    const float sc = __builtin_amdgcn_rsqf(ss + EPS) * (q == 0 ? 0.08838834764831845f : 1.0f);
#pragma unroll
                    for (int j = 0; j < 8; ++j) acc[o][j] *= sc; }
                u32x4 ov; ov.x = cvtpk(acc[o][0], acc[o][1]); ov.y = cvtpk(acc[o][2], acc[o][3]); ov.z = cvtpk(acc[o][4], acc[o][5]); ov.w = cvtpk(acc[o][6], acc[o][7]);
                *(u32x4*)(F.QKN + qkn_idx(b, h, 64 * ck + t0 + o) + q * 128 + c8) = ov;
            }
#pragma unroll
            for (int dy = 0; dy < 2; ++dy)
#pragma unroll
                for (int i = 0; i < 6; ++i) xv[dy][i] = xn[dy][i];
        }
#undef DC_ISSUE
    }
    asm volatile("s_waitcnt vmcnt(0)" ::: "memory");
    __syncthreads();
    const int irow = F.tid >> 3, c16 = (F.tid & 7) * 16;
    u32x4 im[4]; float pla = 0.f, pbe = 0.f;
#define D_ISSUE(u_) do { const int b_ = (u_) / 144, rem_ = (u_) - b_ * 144, h_ = rem_ / 36, ck_ = rem_ - h_ * 36; \
        const bf16* src_ = F.QKN + qkn_idx(b_, h_, 64 * ck_ + irow) + c16; \
        _Pragma("unroll") for (int q = 0; q < 2; ++q) { im[2 * q] = *(const u32x4*)(src_ + 128 * q); im[2 * q + 1] = *(const u32x4*)(src_ + 128 * q + 8); } \
        if (wq == 0) { int ln_ = lane; asm volatile("" : "+v"(ln_)); const int tk_ = dir ? 63 - ln_ : ln_; const size_t tr_ = (size_t)b_ * RPB + 64 * ck_ + tk_; pla = F.LOGA[((size_t)dir * T + tr_) * 4 + h_]; pbe = F.BETA[((size_t)dir * T + tr_) * 4 + h_]; } } while (0)
    const int uend = F.dry == 1 ? 0 : NB * 4 * 36;
    if (F.bx < uend) D_ISSUE(D_UNIT(F.bx));
    for (int uu = F.bx; uu < uend; uu += F.G) {
        const int u = D_UNIT(uu);
        const int b = u / 144, rem = u - b * 144, h = rem / 36, ck = rem - h * 36;
        const int n = dir == 0 ? ck : (ck < 4 ? 3 - ck : 39 - ck);
        const size_t srow0 = (size_t)b * RPB + 64 * n;
#pragma unroll
        for (int q = 0; q < 2; ++q) { *(LAS u32x4*)(L + q * 64 * RS + irow * RS + c16 * 2) = im[2 * q]; *(LAS u32x4*)(L + q * 64 * RS + irow * RS + c16 * 2 + 16) = im[2 * q + 1]; }
        if (wq == 0) {
            int ln_o = F.lane; asm volatile("" : "+v"(ln_o)); const int lane = ln_o;
            float cu = pla;
#pragma unroll
            for (int o = 1; o < 64; o <<= 1) { const float t_ = lane_get(cu, (lane - o) & 63); if (lane >= o) cu += t_; }
            SC[lane] = cu; SC[64 + lane] = pbe; SC[128 + lane] = pbe * __expf(cu);
            F.CUM[((size_t)dir * T + srow0 + lane) * 4 + h] = cu;
        }
        __syncthreads();
        if (uu + F.G < NB * 4 * 36) D_ISSUE(D_UNIT(uu + F.G));
        {
            int c_o = lane & 15, g_o = lane >> 4; asm volatile("" : "+v"(c_o), "+v"(g_o)); const int c = c_o, g = g_o;
            bf16* qkd = QKDg + ((size_t)((dir * 64 + b * 4 + h) * 36 + n)) * 4096;
            const int it = wq;
            f32x4 kk[4], qk[4];
#pragma unroll
            for (int jt = 0; jt < 4; ++jt) { kk[jt] = (f32x4){0.f, 0.f, 0.f, 0.f}; qk[jt] = kk[jt]; }
#pragma unroll
            for (int ks = 0; ks < 4; ++ks) { const int co = (32 * ks + 8 * g) * 2;
                const bf16x8 ak = *(const LAS bf16x8*)(L + D_K + (16 * it + c) * RS + co), aq = *(const LAS bf16x8*)(L + D_Q + (16 * it + c) * RS + co);
#pragma unroll
                for (int jt = 0; jt < 4; ++jt) { const bf16x8 bk = *(const LAS bf16x8*)(L + D_K + (4 * c + jt) * RS + co); kk[jt] = MFMA16(ak, bk, kk[jt]); qk[jt] = MFMA16(aq, bk, qk[jt]); } }
#pragma unroll
            for (int jj = 0; jj < 4; ++jj) { const int toki = 16 * it + 4 * g + jj, i = dir ? 63 - toki : toki; const float ci = SC[i], be_i = SC[64 + i];
                float nb4[4], qk4[4];
#pragma unroll
                for (int jt = 0; jt < 4; ++jt) { const int tokj = 4 * c + jt, ip = dir ? 63 - tokj : tokj;
                    const float dec = __expf(fminf(ci - SC[ip], 0.f));
                    const float nv = (i > ip) ? be_i * kk[jt][jj] * dec : 0.f;
                    const bool same = (i >> 4) == (ip >> 4);
                    *(same ? &ND[((i >> 4) * 16 + (i & 15)) * 17 + (ip & 15)] : (LAS float*)(L + D_DUM) + (lane & 63)) = nv;
                    nb4[jt] = same ? 0.f : -nv;
                    qk4[jt] = (i >= ip) ? qk[jt][jj] * dec : 0.f; }
                u32x2 nbw, qkw;
                if (dir == 0) { nbw.x = cvtpk(nb4[0], nb4[1]); nbw.y = cvtpk(nb4[2], nb4[3]); qkw.x = cvtpk(qk4[0], qk4[1]); qkw.y = cvtpk(qk4[2], qk4[3]); }
                else { nbw.x = cvtpk(nb4[3], nb4[2]); nbw.y = cvtpk(nb4[1], nb4[0]); qkw.x = cvtpk(qk4[3], qk4[2]); qkw.y = cvtpk(qk4[1], qk4[0]); }
                const int col0 = dir ? 60 - 4 * c : 4 * c;
                *(LAS u32x2*)(NBi + i * NRS + col0 * 2) = nbw;
                *(u32x2*)(qkd + i * 64 + col0) = qkw; }
        }
        __syncthreads();
        if (wq == 0) {
            int c_o = lane & 15, g_o = lane >> 4; asm volatile("" : "+v"(c_o), "+v"(g_o)); const int c = c_o, g = g_o;
            float Tc[16];
#pragma unroll
            for (int r = 0; r < 16; ++r) { float a = (r == c) ? 1.f : 0.f;
#pragma unroll
                for (int s2 = 0; s2 < r; ++s2) a -= ND[(g * 16 + r) * 17 + s2] * Tc[s2];
                Tc[r] = a; }
#pragma unroll
            for (int r = 0; r < 16; ++r) *(LAS bf16*)(Ti + (16 * g + r) * TRS + c * 2) = (bf16)(cvtpk(Tc[r], 0.f) & 0xffffu);
        }
        __syncthreads();
        if (wq == 0) {
            int c_o = lane & 15, g_o = lane >> 4; asm volatile("" : "+v"(c_o), "+v"(g_o)); const int c = c_o, g = g_o;
            bf16* og = Wg + ((size_t)((dir * 64 + b * 4 + h) * 36 + n)) * 4096 + 4 * c;
            bf16x8 An[4], ATv[4];
#define D_NFRAG(i_, ks_) cat8(*(const LAS s16x4*)(NBi + (16 * (i_) + c) * NRS + (32 * (ks_) + 4 * g) * 2), *(const LAS s16x4*)(NBi + (16 * (i_) + c) * NRS + (32 * (ks_) + 16 + 4 * g) * 2))
            An[0] = D_NFRAG(1, 0); An[1] = D_NFRAG(2, 0); An[2] = D_NFRAG(3, 0); An[3] = D_NFRAG(3, 1);
#undef D_NFRAG
            { const s16x4 z4 = {0, 0, 0, 0};
#pragma unroll
              for (int i = 0; i < 4; ++i) ATv[i] = cat8(*(const LAS s16x4*)(Ti + (16 * i + c) * TRS + 4 * g * 2), z4); }
            f32x4 Xt[4][4];
#pragma unroll
            for (int i = 0; i < 4; ++i) {
                f32x4 acc[4];
#pragma unroll
                for (int jj = 0; jj < 4; ++jj)
#pragma unroll
                    for (int nt = 0; nt < 4; ++nt) acc[nt][jj] = (16 * i + 4 * g + jj == 4 * c + nt) ? 1.f : 0.f;
                if (i >= 1) {
#pragma unroll
                    for (int nt = 0; nt < 4; ++nt) { const bool two = i >= 2;
                        const bf16x8 B = pack8(Xt[0][nt][0], Xt[0][nt][1], Xt[0][nt][2], Xt[0][nt][3], two ? Xt[1][nt][0] : 0.f, two ? Xt[1][nt][1] : 0.f, two ? Xt[1][nt][2] : 0.f, two ? Xt[1][nt][3] : 0.f);
                        acc[nt] = MFMA16(An[i - 1], B, acc[nt]); } }
                if (i == 3) {
#pragma unroll
                    for (int nt = 0; nt < 4; ++nt) { const bf16x8 B = pack8(Xt[2][nt][0], Xt[2][nt][1], Xt[2][nt][2], Xt[2][nt][3], 0.f, 0.f, 0.f, 0.f);
                        acc[nt] = MFMA16(An[3], B, acc[nt]); } }
#pragma unroll
                for (int nt = 0; nt < 4; ++nt) { const bf16x8 BY = pack8(acc[nt][0], acc[nt][1], acc[nt][2], acc[nt][3], 0.f, 0.f, 0.f, 0.f);
                    Xt[i][nt] = MFMA16(ATv[i], BY, ((f32x4){0.f, 0.f, 0.f, 0.f})); }
#pragma unroll
                for (int jj = 0; jj < 4; ++jj) { u32x2 ov_; ov_.x = cvtpk(Xt[i][0][jj], Xt[i][1][jj]); ov_.y = cvtpk(Xt[i][2][jj], Xt[i][3][jj]);
                    *(u32x2*)(og + (16 * i + 4 * g + jj) * 64) = ov_; }
            }
        }
        __syncthreads();
    }
#undef D_ISSUE
#undef D_UNIT
}

constexpr int E_W = 0, E_U = 64 * RS, E_QD = 2 * 64 * RS, E_KD = 3 * 64 * RS, E_QK = 4 * 64 * RS, E_TI = E_QK + 64 * NRS, E_OST = E_TI + 64 * NRS, E_GT = E_OST + 64 * RS;
static_assert(E_GT + 64 <= RING_BYTES, "DeltaNet LDS map");
DI void dn_unit(Frame& F, int unit) {
    make_frame(F);
    const int b = unit >> 3, h = (unit >> 1) & 3, dir = unit & 1;
    LAS unsigned char* L = F.lds;
    const int lane = F.lane, w = F.wave, c = lane & 15, g = lane >> 4, q4 = (lane & 15) >> 2, p = lane & 3;
    const int e0 = 16 * w;
    const int row = F.tid >> 3, c16 = (F.tid & 7) * 16;
    const bf16* QKN = F.QKN;
    const bf16* TIg = F.Wb + (size_t)((dir * 64 + b * 4 + h) * 36) * 4096;
    const float* BETAg = F.BETA + ((size_t)dir * T + (size_t)b * RPB) * 4 + h;
    bf16* Ug = F.Ub + wu_idx(dir, b, h, 0);
    const bf16* QKDg = F.QKDb + (size_t)((dir * 64 + b * 4 + h) * 36) * 4096;
    const float* CUMg = F.CUM + ((size_t)dir * T + (size_t)b * RPB) * 4 + h;
    f32x4 S[8];
#pragma unroll
    for (int dt = 0; dt < 8; ++dt) S[dt] = (f32x4){0.f, 0.f, 0.f, 0.f};
    constexpr int NCH = RPB / 64;
    struct DnRegs { u32x4 rti, rv0, rv1, rq0, rq1, rk0, rk1, rqk; float rcu, rcl, rbe; };
    DnRegs RG[2];
    const unsigned be_off = (unsigned)(dir == 0 ? row : 63 - row) * 16u, q_off = (unsigned)((dir == 0 ? row : 63 - row) * 384 + c16) * 2u, qk_off = (unsigned)F.tid * 16u, cu_off = (unsigned)row * 16u;
#define DN_LOAD(n, R) do { const int br_ = dir == 0 ? (n) * 64 : ((n) < CTXL / 64 ? CTXL - 64 - (n) * 64 : RPB + CTXL - 64 - (n) * 64); \
        const char* pq_ = (const char*)(QKN + qkn_idx(b, h, br_)); const char* pc_ = (const char*)(CUMg + (size_t)(n) * 64 * 4); \
        R.rq0 = *(const u32x4*)(pq_ + q_off); R.rq1 = *(const u32x4*)(pq_ + q_off + 16); R.rk0 = *(const u32x4*)(pq_ + q_off + 256); R.rk1 = *(const u32x4*)(pq_ + q_off + 272); \
        R.rv0 = *(const u32x4*)(pq_ + q_off + 512); R.rv1 = *(const u32x4*)(pq_ + q_off + 528); \
        R.rti = *(const u32x4*)((const char*)(TIg + (size_t)(n) * 4096) + qk_off); \
        R.rqk = *(const u32x4*)((const char*)(QKDg + (size_t)(n) * 4096) + qk_off); R.rcu = *(const float*)(pc_ + cu_off); R.rcl = *(const float*)(pc_ + 63 * 16); \
        R.rbe = *(const float*)((const char*)(BETAg + (size_t)br_ * 4) + be_off); } while (0)
#define DN_SCALE8(dst, src, f) do { dst.x = cvtpk(bflo(src.x) * (f), bfhi(src.x) * (f)); dst.y = cvtpk(bflo(src.y) * (f), bfhi(src.y) * (f)); dst.z = cvtpk(bflo(src.z) * (f), bfhi(src.z) * (f)); dst.w = cvtpk(bflo(src.w) * (f), bfhi(src.w) * (f)); } while (0)
#define DN_WRITE(R) do { const int o_ = row * RS + c16 * 2, op_ = row * RS + (32 * (c16 >> 5) + 4 * ((c16 >> 4) & 1)) * 2; \
        const float fq_ = __expf(R.rcu), fk_ = __expf(R.rcl - R.rcu), fc_ = R.rbe * fq_; u32x4 t_; \
        DN_SCALE8(t_, R.rk0, fc_); *(LAS u32x2*)(L + E_W + op_) = (u32x2){t_.x, t_.y}; *(LAS u32x2*)(L + E_W + op_ + 16) = (u32x2){t_.z, t_.w}; \
        DN_SCALE8(t_, R.rk1, fc_); *(LAS u32x2*)(L + E_W + op_ + 32) = (u32x2){t_.x, t_.y}; *(LAS u32x2*)(L + E_W + op_ + 48) = (u32x2){t_.z, t_.w}; \
        DN_SCALE8(t_, R.rv0, R.rbe); *(LAS u32x4*)(L + E_U + o_) = t_; DN_SCALE8(t_, R.rv1, R.rbe); *(LAS u32x4*)(L + E_U + o_ + 16) = t_; \
        DN_SCALE8(t_, R.rq0, fq_); *(LAS u32x2*)(L + E_QD + op_) = (u32x2){t_.x, t_.y}; *(LAS u32x2*)(L + E_QD + op_ + 16) = (u32x2){t_.z, t_.w}; \
        DN_SCALE8(t_, R.rq1, fq_); *(LAS u32x2*)(L + E_QD + op_ + 32) = (u32x2){t_.x, t_.y}; *(LAS u32x2*)(L + E_QD + op_ + 48) = (u32x2){t_.z, t_.w}; \
        DN_SCALE8(t_, R.rk0, fk_); *(LAS u32x4*)(L + E_KD + o_) = t_; DN_SCALE8(t_, R.rk1, fk_); *(LAS u32x4*)(L + E_KD + o_ + 16) = t_; \
        *(LAS u32x4*)(L + E_QK + (F.tid >> 3) * NRS + (F.tid & 7) * 16) = R.rqk; *(LAS u32x4*)(L + E_TI + (F.tid >> 3) * NRS + (F.tid & 7) * 16) = R.rti; \
        if (F.tid == 0) *(LAS float*)(L + E_GT) = __expf(R.rcl); } while (0)
    DN_LOAD(0, RG[0]); DN_LOAD(1, RG[1]);
    for (int n2 = 0; n2 < NCH; n2 += 2) {
#pragma unroll
      for (int hh = 0; hh < 2; ++hh) {
        const int n = n2 + hh;
        DN_WRITE(RG[hh]);
        __syncthreads();
        if (n + 2 < NCH) DN_LOAD(n + 2, RG[hh]);
        __builtin_amdgcn_sched_barrier(0);
        {
#define SB() __builtin_amdgcn_sched_barrier(0)
#define DN_LDWQ(fw, fq, ks, mh) do { _Pragma("unroll") for (int m2 = 0; m2 < 2; ++m2) { const int ro_ = (16 * (2 * (mh) + m2) + c) * RS + (32 * (ks) + 8 * g) * 2; \
                fw[m2] = *(const LAS bf16x8*)(L + E_W + ro_); fq[m2] = *(const LAS bf16x8*)(L + E_QD + ro_); } } while (0)
#define DN_PACKS(ks) do { \
            Bs_ = pack8(S[2 * (ks)][0], S[2 * (ks)][1], S[2 * (ks)][2], S[2 * (ks)][3], S[2 * (ks) + 1][0], S[2 * (ks) + 1][1], S[2 * (ks) + 1][2], S[2 * (ks) + 1][3]); \
            Bn_ = pack8(-S[2 * (ks)][0], -S[2 * (ks)][1], -S[2 * (ks)][2], -S[2 * (ks)][3], -S[2 * (ks) + 1][0], -S[2 * (ks) + 1][1], -S[2 * (ks) + 1][2], -S[2 * (ks) + 1][3]); } while (0)
#define DN_MMWQ(fw, fq, mh) do { _Pragma("unroll") for (int m2 = 0; m2 < 2; ++m2) { vn[2 * (mh) + m2] = MFMA16(fw[m2], Bn_, vn[2 * (mh) + m2]); oo[2 * (mh) + m2] = MFMA16(fq[m2], Bs_, oo[2 * (mh) + m2]); } } while (0)
#define DN_LDK(fk, dt0) do { _Pragma("unroll") for (int d_ = 0; d_ < 4; ++d_) _Pragma("unroll") for (int ks = 0; ks < 2; ++ks) \
                fk[d_][ks] = cat8(ds_tr(L + E_KD + (32 * ks + 4 * g + q4) * RS + (16 * ((dt0) + d_) + 4 * p) * 2), ds_tr(L + E_KD + (32 * ks + 16 + 4 * g + q4) * RS + (16 * ((dt0) + d_) + 4 * p) * 2)); } while (0)
#define DN_MMK(fk, dt0) do { _Pragma("unroll") for (int d_ = 0; d_ < 4; ++d_) { f32x4 sv_ = S[(dt0) + d_] * gt; sv_ = MFMA16(fk[d_][0], Bv[0], sv_); sv_ = MFMA16(fk[d_][1], Bv[1], sv_); S[(dt0) + d_] = sv_; } } while (0)
            f32x4 vn[4], oo[4];
            bf16x8 f0w[2], f0q[2], f1w[2], f1q[2], Bs_, Bn_;
            DN_LDWQ(f0w, f0q, 0, 0);
#pragma unroll
            for (int mt = 0; mt < 4; ++mt)
#pragma unroll
                for (int jj = 0; jj < 4; ++jj) vn[mt][jj] = bf2f(*(const LAS bf16*)(L + E_U + (16 * mt + 4 * g + jj) * RS + (e0 + c) * 2));
#pragma unroll
            for (int mt = 0; mt < 4; ++mt) oo[mt] = (f32x4){0.f, 0.f, 0.f, 0.f};
            const float gt = *(const LAS float*)(L + E_GT);
            SB(); DN_LDWQ(f1w, f1q, 0, 1); DN_PACKS(0); SB(); DN_MMWQ(f0w, f0q, 0); SB();
            DN_LDWQ(f0w, f0q, 1, 0); SB(); DN_MMWQ(f1w, f1q, 1); SB();
            DN_LDWQ(f1w, f1q, 1, 1); DN_PACKS(1); SB(); DN_MMWQ(f0w, f0q, 0); SB();
            DN_LDWQ(f0w, f0q, 2, 0); SB(); DN_MMWQ(f1w, f1q, 1); SB();
            DN_LDWQ(f1w, f1q, 2, 1); DN_PACKS(2); SB(); DN_MMWQ(f0w, f0q, 0); SB();
            DN_LDWQ(f0w, f0q, 3, 0); SB(); DN_MMWQ(f1w, f1q, 1); SB();
            DN_LDWQ(f1w, f1q, 3, 1); DN_PACKS(3); SB(); DN_MMWQ(f0w, f0q, 0); SB();
            DN_MMWQ(f1w, f1q, 1); SB();
            bf16x8 ta[2][4];
#pragma unroll
            for (int ks = 0; ks < 2; ++ks)
#pragma unroll
                for (int mt = 0; mt < 4; ++mt) { const int ro = (16 * mt + c) * NRS + (32 * ks + 4 * g) * 2; ta[ks][mt] = cat8(*(const LAS s16x4*)(L + E_TI + ro), *(const LAS s16x4*)(L + E_TI + ro + 32)); }
            SB();
            bf16x8 fa[2][4];
#pragma unroll
            for (int ks = 0; ks < 2; ++ks)
#pragma unroll
                for (int mt = 0; mt < 4; ++mt) { const int ro = (16 * mt + c) * NRS + (32 * ks + 4 * g) * 2; fa[ks][mt] = cat8(*(const LAS s16x4*)(L + E_QK + ro), *(const LAS s16x4*)(L + E_QK + ro + 32)); }
            SB();
            {
                bf16x8 Br[2];
#pragma unroll
                for (int ks = 0; ks < 2; ++ks) Br[ks] = pack8(vn[2 * ks][0], vn[2 * ks][1], vn[2 * ks][2], vn[2 * ks][3], vn[2 * ks + 1][0], vn[2 * ks + 1][1], vn[2 * ks + 1][2], vn[2 * ks + 1][3]);
#pragma unroll
                for (int mt = 0; mt < 4; ++mt) { vn[mt] = MFMA16(ta[0][mt], Br[0], ((f32x4){0.f, 0.f, 0.f, 0.f})); vn[mt] = MFMA16(ta[1][mt], Br[1], vn[mt]); }
            }
            bf16x8 k0[4][2];
            DN_LDK(k0, 0); SB();
            bf16x8 Bv[2];
#pragma unroll
            for (int ks = 0; ks < 2; ++ks) Bv[ks] = pack8(vn[2 * ks][0], vn[2 * ks][1], vn[2 * ks][2], vn[2 * ks][3], vn[2 * ks + 1][0], vn[2 * ks + 1][1], vn[2 * ks + 1][2], vn[2 * ks + 1][3]);
#pragma unroll
            for (int ks = 0; ks < 2; ++ks)
#pragma unroll
                for (int mt = 0; mt < 4; ++mt) oo[mt] = MFMA16(fa[ks][mt], Bv[ks], oo[mt]);
            SB(); DN_MMK(k0, 0); SB(); DN_LDK(k0, 4); SB();
#pragma unroll
            for (int mt = 0; mt < 4; ++mt)
#pragma unroll
                for (int jj = 0; jj < 4; ++jj) *(LAS bf16*)(L + E_OST + (16 * mt + 4 * g + jj) * RS + (e0 + c) * 2) = (bf16)(cvtpk(oo[mt][jj], 0.f) & 0xffffu);
            DN_MMK(k0, 4);
#undef DN_LDWQ
#undef DN_MMWQ
#undef DN_PACKS
#undef DN_LDK
#undef DN_MMK
#undef SB
        }
        __syncthreads();
        {
            const u32x4 o0 = *(const LAS u32x4*)(L + E_OST + row * RS + c16 * 2), o1 = *(const LAS u32x4*)(L + E_OST + row * RS + c16 * 2 + 16);
            bf16* po = Ug + ((size_t)n * 64 + row) * 128 + c16;
            if (!F.dry) { *(u32x4*)po = o0; *(u32x4*)(po + 8) = o1; }
        }
      }
    }
    __syncthreads();
#undef DN_LOAD
#undef DN_SCALE8
#undef DN_WRITE
}

DI void phase_E_naive(Frame& F) {
    for (int u = F.bx; u < 256; u += F.G) { if (u < 128) { if (F.dry != 2) hg_unit(F, u); } else { if (F.dry != 1) dn_unit(F, u - 128); } }
}

DI void phase_F(Frame& F, int l) {
    make_frame(F);
    const int gw = F.bx * 8 + F.wave, NGW = F.G * 8;
    const bf16* U = F.Ub; bf16* MIX = F.HBQ;
    const int grp = F.lane >> 5, cg = (F.lane & 31) * 16;
    const float* nw = (grp == 0 ? F.hg_norm_w : F.dn_norm_w) + l * HD + (cg & 127);
    float nwv[16];
#pragma unroll
    for (int j = 0; j < 16; ++j) nwv[j] = nw[j];
    for (int t = gw; t < T; t += NGW) {
        const bf16 *pf, *pb, *pg;
        const int bb = t / RPB, rr = t - bb * RPB, hh = cg >> 7, dd = cg & 127;
        if (grp == 0) { const bf16* p = F.PHG + phg_idx(bb, hh, rr) + dd; pf = p + 256; pb = p + 384; pg = F.PHG + PHG_G + (size_t)t * 512 + cg; }
        else { pf = U + wu_idx(0, bb, hh, rr) + dd; pb = U + wu_idx(1, bb, hh, step_row(1, rr)) + dd; pg = F.PZ + (size_t)t * 512 + cg; }
        float o[16], g[16]; float ss = 0.f;
#pragma unroll
        for (int q = 0; q < 2; ++q) { const u32x4 a = *(const u32x4*)(pf + 8 * q), c = *(const u32x4*)(pb + 8 * q), gg = *(const u32x4*)(pg + 8 * q);
            const unsigned aa[4] = {a.x, a.y, a.z, a.w}, ca[4] = {c.x, c.y, c.z, c.w}, ga[4] = {gg.x, gg.y, gg.z, gg.w};
#pragma unroll
            for (int j = 0; j < 4; ++j) { o[8 * q + 2 * j] = bflo(aa[j]) + bflo(ca[j]); o[8 * q + 2 * j + 1] = bfhi(aa[j]) + bfhi(ca[j]); g[8 * q + 2 * j] = bflo(ga[j]); g[8 * q + 2 * j + 1] = bfhi(ga[j]); } }
#pragma unroll
        for (int j = 0; j < 16; ++j) ss += o[j] * o[j];
        ss += swz<1>(ss); ss += swz<2>(ss); ss += swz<4>(ss);
        const float rstd = __builtin_amdgcn_rsqf(ss * (1.0f / HD) + EPS);
        unsigned w[8];
#pragma unroll
        for (int j = 0; j < 8; ++j) w[j] = cvt_pk_bf16(o[2 * j] * rstd * nwv[2 * j] * silu_f(g[2 * j]), o[2 * j + 1] * rstd * nwv[2 * j + 1] * silu_f(g[2 * j + 1]));
        u32x4* mo = (u32x4*)(MIX + (size_t)t * D + F.lane * 16);
        mo[0] = (u32x4){w[0], w[1], w[2], w[3]}; mo[1] = (u32x4){w[4], w[5], w[6], w[7]};
    }
}

DI void expert_weight_transposes(Frame& F, int l, int rank, int nblk, int part) {
    LAS float* scr = (LAS float*)(F.lds + F.wave * 8448);
    bf16* WGU = (bf16*)((char*)F.out + XO_WGU); bf16* WDN = (bf16*)((char*)F.out + XO_WDN);
    constexpr int I_G = 16 * 16, I_D = 8 * 32;
    if (part == 0) {
        auto dec = [&](int it) -> TrItem { const int e = it / (2 * I_G); int r = it - e * (2 * I_G); const int up = r >= I_G; if (up) r -= I_G; const int kb = r >> 4, nb = r & 15, n0 = 32 * nb;
            return TrItem{(up ? F.w_up : F.w_gate) + ((size_t)l * NE + e) * D * FF, WGU + (size_t)e * D * D, FF, D, 64 * kb, n0, 256 * (n0 >> 7) + (n0 & 127) + (up ? 128 : 0)}; };
        TRANSPOSE_LOOP(rank * 8 + F.wave, NE * 2 * I_G, nblk * 8, dec);
    } else {
        auto dec = [&](int it) -> TrItem { const int e = it / I_D, r = it - e * I_D; const int kb = r >> 5, nb = r & 31;
            return TrItem{F.w_down + ((size_t)l * NE + e) * FF * D, WDN + (size_t)e * D * FF, D, FF, 64 * kb, 32 * nb, 32 * nb}; };
        TRANSPOSE_LOOP(rank * 8 + F.wave, NE * I_D, nblk * 8, dec);
    }
}

constexpr int HW_WT = 0, HW_WSC = 40 * HW_WTS, HW_SH = HW_WSC + 2 * 1024 * 4, HW_LG = HW_SH + 2 * 1024 * 4, HW_RS = HW_LG + 8 * 16 * 25 * 4, HW_RS2 = HW_RS + 8 * 16 * 4, HW_RT = HW_RS2 + 16 * 4;
DI void phase_H(Frame& F, int l) {
    make_frame(F);
    const bool lastl = (l == DEPTH - 1);
    LAS unsigned char* L = F.lds;
    const int lane = F.lane, w = F.wave, c = lane & 15, g = lane >> 4;
    LAS int* rtE = (LAS int*)(L + HW_RT);
    LAS float* rtW = (LAS float*)(rtE + 288);
    LAS int* lcnt = (LAS int*)(rtW + 288);
    LAS int* lbase = lcnt + 16;
    LAS int* lpos = lbase + 16;
    for (int k = F.tid; k < D; k += 512) {
        const f32x4* we = (const f32x4*)(F.w_expert + ((size_t)l * D + k) * 16); const f32x4 wg = *(const f32x4*)(F.w_group + ((size_t)l * D + k) * 4);
#pragma unroll
        for (int q4 = 0; q4 < 4; ++q4) { const f32x4 e4 = we[q4];
#pragma unroll
            for (int j = 0; j < 4; ++j) { const unsigned hi = cvtpk(e4[j], 0.f) & 0xffffu; const unsigned lo = cvtpk(e4[j] - __uint_as_float(hi << 16), 0.f) & 0xffffu;
                *(LAS bf16*)(L + HW_WT + (4 * q4 + j) * HW_WTS + k * 2) = (bf16)hi; *(LAS bf16*)(L + HW_WT + (16 + 4 * q4 + j) * HW_WTS + k * 2) = (bf16)lo; } }
#pragma unroll
        for (int j = 0; j < 4; ++j) { const unsigned hi = cvtpk(wg[j], 0.f) & 0xffffu; const unsigned lo = cvtpk(wg[j] - __uint_as_float(hi << 16), 0.f) & 0xffffu;
            *(LAS bf16*)(L + HW_WT + (32 + j) * HW_WTS + k * 2) = (bf16)hi; *(LAS bf16*)(L + HW_WT + (36 + j) * HW_WTS + k * 2) = (bf16)lo; }
    }
    const float* n2 = F.norm2_w + l * D;
    unsigned* CNT = (unsigned*)(F.ctl + CW_CNT + (l + (F.dry ? DEPTH : 0)) * 16 * 64);
    const int RPU = lastl ? 128 : 144, RPW = RPU / 8, NU = lastl ? NB * (SEQ / 128) : T / 144;
    for (int u = F.bx; u < NU; u += F.G) {
        const int t0 = lastl ? (u >> 4) * RPB + CTXL + (u & 15) * 128 : u * 144;
        const int bblk = t0 / RPB;
        int tid0 = F.tid; asm volatile("" : "+v"(tid0));
        if (tid0 < 16) lcnt[tid0] = 0;
        for (int i = tid0; i < 2 * D; i += 512) { const int cls = i >> 10, k = i & 1023; const float* md = F.MOD + ((size_t)l * 17 + (cls ? 16 : bblk)) * MODW + 3 * D;
            *(LAS float*)(L + HW_WSC + i * 4) = n2[k] * (md[D + k] + 1.0f); *(LAS float*)(L + HW_SH + i * 4) = md[k]; }
        __syncthreads();
#define H_LD(dst, k0, NQ) do { _Pragma("unroll") for (int q_ = 0; q_ < (NQ); ++q_) dst[q_] = *(const u32x4*)(xrow + 32 * ((k0) + q_)); } while (0)
#define H_LOGITS(src, k0, NQ) do { _Pragma("unroll") for (int q_ = 0; q_ < (NQ); ++q_) { const int ks = (k0) + q_; \
                const u32x4 x = src[q_]; const f32x4 w0 = *(const LAS f32x4*)(wscp + ks * 128), w1 = *(const LAS f32x4*)(wscp + ks * 128 + 16); \
                const float x0 = bflo(x.x), x1 = bfhi(x.x), x2 = bflo(x.y), x3 = bfhi(x.y), x4 = bflo(x.z), x5 = bfhi(x.z), x6 = bflo(x.w), x7 = bfhi(x.w); \
                ss8[0] += x0 * x0; ss8[1] += x1 * x1; ss8[2] += x2 * x2; ss8[3] += x3 * x3; ss8[4] += x4 * x4; ss8[5] += x5 * x5; ss8[6] += x6 * x6; ss8[7] += x7 * x7; \
                const float h0 = x0 * w0[0], h1 = x1 * w0[1], h2 = x2 * w0[2], h3 = x3 * w0[3], h4 = x4 * w1[0], h5 = x5 * w1[1], h6 = x6 * w1[2], h7 = x7 * w1[3]; \
                u32x4 ah; ah.x = cvtpk(h0, h1); ah.y = cvtpk(h2, h3); ah.z = cvtpk(h4, h5); ah.w = cvtpk(h6, h7); \
                const bf16x8 Ah = __builtin_bit_cast(bf16x8, ah); \
                const bf16x8 Al = pack8(h0 - bflo(ah.x), h1 - bfhi(ah.x), h2 - bflo(ah.y), h3 - bfhi(ah.y), h4 - bflo(ah.z), h5 - bfhi(ah.z), h6 - bflo(ah.w), h7 - bfhi(ah.w)); \
                const bf16x8 B0 = *(const LAS bf16x8*)(b0p + ks * 64), B1 = *(const LAS bf16x8*)(b1p + ks * 64), B2 = *(const LAS bf16x8*)(b2p + ks * 64); \
                acc0 = MFMA16(Ah, B0, acc0); acc0 = MFMA16(Al, B0, acc0); acc0 = MFMA16(Ah, B1, acc0); acc1 = MFMA16(Ah, B2, acc1); acc1 = MFMA16(Al, B2, acc1); } } while (0)
#define H_OUT(src, k0, NQ) do { _Pragma("unroll") for (int q_ = 0; q_ < (NQ); ++q_) { const int ks = (k0) + q_; \
                const u32x4 x = src[q_]; const f32x4 w0 = *(const LAS f32x4*)(wscp + ks * 128), w1 = *(const LAS f32x4*)(wscp + ks * 128 + 16), s0 = *(const LAS f32x4*)(shp + ks * 128), s1 = *(const LAS f32x4*)(shp + ks * 128 + 16); \
                u32x4 o; o.x = cvtpk(bflo(x.x) * w0[0] * rstd + s0[0], bfhi(x.x) * w0[1] * rstd + s0[1]); o.y = cvtpk(bflo(x.y) * w0[2] * rstd + s0[2], bfhi(x.y) * w0[3] * rstd + s0[3]); \
                o.z = cvtpk(bflo(x.z) * w1[0] * rstd + s1[0], bfhi(x.z) * w1[1] * rstd + s1[1]); o.w = cvtpk(bflo(x.w) * w1[2] * rstd + s1[2], bfhi(x.w) * w1[3] * rstd + s1[3]); \
                *(u32x4*)(ho + 32 * ks) = o; } } while (0)
#define H_ROUTE(LG_, RS_, rowi, rl2) do { const int t2 = t0 + (rl2); const int rr2 = t2 - (t2 / RPB) * RPB, mod2 = rr2 < CTXL ? 16 : bblk; \
                const float* ch = F.CH + (l * 17 + mod2) * 20;        \
                const float rs = RS_[rowi]; \
                float gl[4], ex[16]; \
                _Pragma("unroll") for (int q = 0; q < 16; ++q) ex[q] = LG_[(rowi) * 25 + q] * rs + ch[4 + q]; \
                _Pragma("unroll") for (int q = 0; q < 4; ++q) gl[q] = (LG_[(rowi) * 25 + 16 + q] + LG_[(rowi) * 25 + 20 + q]) * rs + ch[q]; \
                int gi = 0; float gm = gl[0]; \
                _Pragma("unroll") for (int q = 1; q < 4; ++q) if (gl[q] > gm) { gm = gl[q]; gi = q; } \
                float gs = 0.f; \
                _Pragma("unroll") for (int q = 0; q < 4; ++q) gs += expf(gl[q] - gm); \
                const float gwt = 1.0f / gs; \
                float el[4]; \
                _Pragma("unroll") for (int q = 0; q < 4; ++q) el[q] = gi == 0 ? ex[q] : (gi == 1 ? ex[4 + q] : (gi == 2 ? ex[8 + q] : ex[12 + q])); \
                int i1 = 0; float v1 = el[0]; \
                _Pragma("unroll") for (int q = 1; q < 4; ++q) if (el[q] > v1) { v1 = el[q]; i1 = q; } \
                int i2 = -1; float v2 = -3.0e38f; \
                _Pragma("unroll") for (int q = 0; q < 4; ++q) if (q != i1 && el[q] > v2) { v2 = el[q]; i2 = q; } \
                const float e2 = expf(v2 - v1), w1 = gwt / (1.0f + e2), w2 = gwt * e2 / (1.0f + e2); \
                rtE[(rl2) * 2] = gi * 4 + i1; rtE[(rl2) * 2 + 1] = gi * 4 + i2; rtW[(rl2) * 2] = w1; rtW[(rl2) * 2 + 1] = w2; } while (0)
#define SBH() __builtin_amdgcn_sched_barrier(0)
        {
            int c_o = F.lane & 15, g_o = F.lane >> 4, l_o = F.lane; asm volatile("" : "+v"(c_o), "+v"(g_o), "+v"(l_o)); const int c = c_o, g = g_o, lane = l_o;
            const int rl = w * RPW + c, t = t0 + rl;
            const int rr = t - (t / RPB) * RPB, cls = rr < CTXL ? 1 : 0;
            const bf16* xrow = F.XS + (size_t)t * D + 8 * g;
            f32x4 acc0 = {0.f, 0.f, 0.f, 0.f}, acc1 = acc0; float ss8[8] = {0.f, 0.f, 0.f, 0.f, 0.f, 0.f, 0.f, 0.f};
            const LAS unsigned char* wscp = L + HW_WSC + (cls * D + 8 * g) * 4; const LAS unsigned char* shp = L + HW_SH + (cls * D + 8 * g) * 4;
            const LAS unsigned char* b0p = L + HW_WT + c * HW_WTS + 8 * g * 2; const LAS unsigned char* b1p = b0p + 16 * HW_WTS; const LAS unsigned char* b2p = L + HW_WT + (32 + (c & 7)) * HW_WTS + 8 * g * 2;
            u32x4 xa[8], xb[8];
            H_LD(xa, 0, 8); SBH();
            H_LD(xb, 8, 8); SBH(); H_LOGITS(xa, 0, 8); SBH();
            H_LD(xa, 16, 8); SBH(); H_LOGITS(xb, 8, 8); SBH();
            H_LD(xb, 24, 8); SBH(); H_LOGITS(xa, 16, 8); SBH();
            H_LD(xa, 0, 8); SBH(); H_LOGITS(xb, 24, 8); SBH();
            float ss = ((ss8[0] + ss8[1]) + (ss8[2] + ss8[3])) + ((ss8[4] + ss8[5]) + (ss8[6] + ss8[7])); ss += swz<16>(ss); ss = add_x32(ss);
            const float rstd = 1.0f / sqrtf(ss * (1.0f / D) + EPS);
            LAS float* LG = (LAS float*)(L + HW_LG + w * 16 * 25 * 4); LAS float* RSD = (LAS float*)(L + HW_RS + w * 64);
#pragma unroll
            for (int j = 0; j < 4; ++j) { LG[(4 * g + j) * 25 + c] = acc0[j]; if (c < 8) LG[(4 * g + j) * 25 + 16 + c] = acc1[j]; }
            if (g == 0) RSD[c] = rstd;
            bf16* ho = F.HBQ + (size_t)t * D + 8 * g;
            H_LD(xb, 8, 8); SBH(); H_OUT(xa, 0, 8); SBH();
            H_LD(xa, 16, 8); SBH(); H_OUT(xb, 8, 8); SBH();
            H_LD(xb, 24, 8); SBH(); H_OUT(xa, 16, 8); SBH();
            H_OUT(xb, 24, 8);
            asm volatile("s_waitcnt lgkmcnt(0)" ::: "memory");
            __builtin_amdgcn_wave_barrier();
            if (lane < 16) H_ROUTE(LG, RSD, lane, w * RPW + lane);
            __builtin_amdgcn_wave_barrier();
        }
        if (RPW > 16) {
            int c_o = F.lane & 15, g_o = F.lane >> 4, l_o = F.lane; asm volatile("" : "+v"(c_o), "+v"(g_o), "+v"(l_o)); const int c = c_o, g = g_o, lane = l_o;
            const int rl = (c >> 1) * RPW + 16 + (c & 1), t = t0 + rl;
            const int rr = t - (t / RPB) * RPB, cls = rr < CTXL ? 1 : 0;
            const bf16* xrow = F.XS + (size_t)t * D + 128 * w + 8 * g;
            f32x4 acc0 = {0.f, 0.f, 0.f, 0.f}, acc1 = acc0; float ss8[8] = {0.f, 0.f, 0.f, 0.f, 0.f, 0.f, 0.f, 0.f};
            const LAS unsigned char* wscp = L + HW_WSC + (cls * D + 128 * w + 8 * g) * 4; const LAS unsigned char* shp = L + HW_SH + (cls * D + 128 * w + 8 * g) * 4;
            const LAS unsigned char* b0p = L + HW_WT + c * HW_WTS + (128 * w + 8 * g) * 2; const LAS unsigned char* b1p = b0p + 16 * HW_WTS; const LAS unsigned char* b2p = L + HW_WT + (32 + (c & 7)) * HW_WTS + (128 * w + 8 * g) * 2;
            u32x4 xs[4];
            H_LD(xs, 0, 4); SBH(); H_LOGITS(xs, 0, 4); SBH();
            float ss = ((ss8[0] + ss8[1]) + (ss8[2] + ss8[3])) + ((ss8[4] + ss8[5]) + (ss8[6] + ss8[7])); ss += swz<16>(ss); ss = add_x32(ss);
            LAS float* LG = (LAS float*)(L + HW_LG + w * 16 * 25 * 4); LAS float* RSD = (LAS float*)(L + HW_RS + w * 64);
#pragma unroll
            for (int j = 0; j < 4; ++j) { LG[(4 * g + j) * 25 + c] = acc0[j]; if (c < 8) LG[(4 * g + j) * 25 + 16 + c] = acc1[j]; }
            if (g == 0) RSD[c] = ss;
            __syncthreads();
            float sst = 0.f;
#pragma unroll
            for (int w2 = 0; w2 < 8; ++w2) sst += *(const LAS float*)(L + HW_RS + w2 * 64 + c * 4);
            const float rstd = 1.0f / sqrtf(sst * (1.0f / D) + EPS);
            bf16* ho = F.HBQ + (size_t)t * D + 128 * w + 8 * g;
            H_OUT(xs, 0, 4);
            if (w == 0) {
                LAS float* LG0 = (LAS float*)(L + HW_LG); LAS float* RS2 = (LAS float*)(L + HW_RS2);
                for (int i = lane; i < 16 * 25; i += 64) { float a = LG0[i];
#pragma unroll
                    for (int w2 = 1; w2 < 8; ++w2) a += LG0[w2 * 16 * 25 + i];
                    LG0[i] = a; }
                if (g == 0) RS2[c] = rstd;
                asm volatile("s_waitcnt lgkmcnt(0)" ::: "memory");
                __builtin_amdgcn_wave_barrier();
                if (lane < 16) H_ROUTE(LG0, RS2, lane, (lane >> 1) * RPW + 16 + (lane & 1));
            }
        }
#undef H_LD
#undef H_LOGITS
#undef H_OUT
#undef H_ROUTE
#undef SBH
        __syncthreads();
        int tid = F.tid; asm volatile("" : "+v"(tid));
        if (tid < 2 * RPU) lpos[tid] = __hip_atomic_fetch_add(&lcnt[rtE[tid]], 1, __ATOMIC_RELAXED, __HIP_MEMORY_SCOPE_WORKGROUP);
        __syncthreads();
        if (tid < 16) lbase[tid] = (int)__hip_atomic_fetch_add(CNT + tid * 64, (unsigned)lcnt[tid], RLX_AGENT);
        __syncthreads();
        if (tid < 2 * RPU && !F.dry) { const int e = rtE[tid], pos = lbase[e] + lpos[tid]; F.LIST[e * T + pos] = (t0 + (tid >> 1)) * 2 + (tid & 1); F.LISTW[e * T + pos] = rtW[tid]; }
        __syncthreads();
    }
}

DI int build_tiles(Frame& F, int l) {
    make_frame(F);
    LAS int* TE = (LAS int*)(F.lds + TAB_OFF); LAS int* TR0 = TE + MAXTILES; LAS int* NEc = TR0 + MAXTILES; LAS int* NTp = NEc + 16;
    if (F.tid == 0) {
        int nt = 0;
        for (int e = 0; e < NE; ++e) { int n = (int)__hip_atomic_load((unsigned*)(F.ctl + CW_CNT + (l * 16 + e) * 64), RLX_AGENT); if (n > T) n = T; NEc[e] = n;
            for (int r0 = 0; r0 < n && nt < MAXTILES; r0 += 256) { TE[nt] = e; TR0[nt] = r0; ++nt; } }
        NTp[0] = nt;
    }
    __syncthreads();
    return __builtin_amdgcn_readfirstlane(NTp[0]);
}

DI void phase_Z(Frame& F) {
    make_frame(F);
    const int gw = F.bx * 8 + F.wave, NGW = F.G * 8;
    for (int i = gw; i < NB * SEQ; i += NGW) {
        const int b = i / SEQ, j0 = i - b * SEQ, r = CTXL + j0, t = b * RPB + r;
        f32x4 v[4]; load_xrow(F, DEPTH, t, b, r, b, v);
        const float rstd = row_rstd(v);
        f32x4* o = (f32x4*)(F.out + (size_t)i * D);
#pragma unroll
        for (int j = 0; j < 4; ++j) { const int e = F.lane + 64 * j; o[e] = v[j] * rstd * ((const f32x4*)F.final_norm_w)[e]; }
    }
}

constexpr int NPH_L = 10;
constexpr int NPHASES = 2 + DEPTH * NPH_L + 1;
__global__ void __launch_bounds__(512, 2) fwd_kernel(Args args) {
    extern __shared__ __attribute__((aligned(16))) unsigned char lds_raw[];
    Frame F; { int w_ = __builtin_amdgcn_readfirstlane((int)threadIdx.x >> 6); asm volatile("" : "+s"(w_)); F.wsg = w_; } make_frame(F);
    for (int u = F.tid; u < (LDS_BYTES - LDSCTL_OFF) / 4; u += 512) ((LAS unsigned*)(F.lds + LDSCTL_OFF))[u] = 0u;
    __syncthreads();
    volatile LAS unsigned* MISC = (volatile LAS unsigned*)(F.lds + MISC_OFF);
    XcdBarrier bar; bar.bar = (unsigned*)(F.ctl + CW_BAR); bar.x = 0; bar.st = nullptr;
#if !MK_PER_PHASE_LAUNCH
    bar = xcd_barrier_post((unsigned*)(F.ctl + CW_BAR + (args.bar_slot ? 28672 + args.bar_slot * 4096 : 0)), MISC + 8, F.tid == 0);
#endif
    const int lo = args.ph_lo, hi = args.ph_hi & 0xffff;
#define IN(k) (lo <= (k) && (k) < hi)
#if MK_PER_PHASE_LAUNCH
#define SEAM(k) do { } while (0)
#else
#define SEAM(k) do { if (IN(k) && IN((k) + 1)) { make_frame(F); xcd_barrier(bar, F.tid == 0); } } while (0)
#endif
    if (IN(0)) { phase_prologue(F); } SEAM(0);
    if (IN(1)) { phase_consts(F); } SEAM(1);
    for (int l = 0; l < DEPTH; ++l) {
        const int p0 = 2 + l * NPH_L;
        const bool lastl = (l == DEPTH - 1);
        if (IN(p0 + 0)) { phase_A(F, l); } SEAM(p0 + 0);
        if (IN(p0 + 1)) {
            make_frame(F);
            pg8::DenseSched S; S.so.init(T, NP, F.G, F.bx); S.Bt = (const char*)F.WIN; S.K = D; S.skipctx = 0;
            pg8::EpiInProj E{F.PHG, F.PREP, F.PZ, F.LB + l * 1024};
            pg8::gemm_phase<pg8::EpiInProj, pg8::DenseSched, true>(F.lds, F.tid, (const char*)F.HBQ, D, S, E);
            {
                make_frame(F);
                const int nun = (T / 256) * (NP / 256), nex = nun % F.G;
                if (nex == 0) expert_weight_transposes(F, l, F.bx, F.G, 0); else if (F.bx >= nex) expert_weight_transposes(F, l, F.bx - nex, F.G - nex, 0);
            }
        } SEAM(p0 + 1);
        if (IN(p0 + 3)) { phase_D(F, l); } SEAM(p0 + 3);
        if (IN(p0 + 4)) { phase_E_naive(F); } SEAM(p0 + 4);
        if (IN(p0 + 5)) { phase_F(F, l); } SEAM(p0 + 5);
        if (IN(p0 + 6)) {
            make_frame(F);
            pg8::DenseSched S; S.so.init(lastl ? NB * SEQ : T, D, F.G, F.bx); S.Bt = (const char*)wout_buf(F, l); S.K = D; S.skipctx = lastl ? 1 : 0;
            pg8::EpiOutProj E{F.XS, F.MOD + (size_t)l * 17 * MODW + 2 * D, F.dry ? 0.f : 1.f};
            pg8::gemm_phase<pg8::EpiOutProj, pg8::DenseSched, true>(F.lds, F.tid, (const char*)F.HBQ, D, S, E);
            {
                make_frame(F);
                const int nun = (lastl ? NB * SEQ : T) / 256 * (D / 256), nex = nun % F.G;
                const int rank = nex == 0 ? F.bx : F.bx - nex, nblk = nex == 0 ? F.G : F.G - nex;
                if (rank >= 0) { expert_weight_transposes(F, l, rank, nblk, 1); if (!lastl) inout_weight_transposes(F, l + 1, rank, nblk); }
            }
        } SEAM(p0 + 6);
        if (IN(p0 + 7)) { phase_H(F, l); } SEAM(p0 + 7);
        if (IN(p0 + 8)) {
            const int NT = build_tiles(F, l);
            LAS int* TE = (LAS int*)(F.lds + TAB_OFF);
            pg8::GroupSched<true> S{TE, TE + MAXTILES, TE + 2 * MAXTILES, NT, F.G, F.bx, (const char*)F.out + XO_WGU, (size_t)D * D * 2, D, F.LIST};
            pg8::EpiSwiGLU E{F.PREP + PREP_ACT / 2};
            pg8::gemm_phase<pg8::EpiSwiGLU, pg8::GroupSched<true>, true>(F.lds, F.tid, (const char*)F.HBQ, D, S, E);
        } SEAM(p0 + 8);
        if (IN(p0 + 9)) {
            const int NT = build_tiles(F, l);
            LAS int* TE = (LAS int*)(F.lds + TAB_OFF);
            pg8::GroupSched<false> S{TE, TE + MAXTILES, TE + 2 * MAXTILES, NT, F.G, F.bx, (const char*)F.out + XO_WDN, (size_t)D * FF * 2, FF, F.LIST};
            pg8::EpiDown E{F.PHG, F.LIST, F.LISTW, F.lds};
            pg8::gemm_phase<pg8::EpiDown, pg8::GroupSched<false>, true>(F.lds, F.tid, (const char*)(F.PREP + PREP_ACT / 2), FF, S, E);
        } SEAM(p0 + 9);
    }
    if (IN(NPHASES - 1)) { phase_Z(F); }
#undef IN
#undef SEAM
}

extern "C" void kernel_launch(void* const* d_in, const int* in_sizes, int n_in, void* d_out, int out_size, void* d_ws, size_t ws_size, hipStream_t stream) {
    static int grid = 0;
    if (grid == 0) {
        if (n_in != 24 || out_size != NB * SEQ * D || ws_size < WS_END) { fprintf(stderr, "kernel_launch: unexpected problem (n_in %d, out %d, ws %zu < %zu)\n", n_in, out_size, ws_size, (size_t)WS_END); grid = -1; return; }
        int dev = 0, cus = 0, per_cu = 0;
        if (hipGetDevice(&dev) != hipSuccess || hipDeviceGetAttribute(&cus, hipDeviceAttributeMultiprocessorCount, dev) != hipSuccess) { grid = -1; return; }
        if (hipFuncSetAttribute((const void*)fwd_kernel, hipFuncAttributeMaxDynamicSharedMemorySize, LDS_BYTES) != hipSuccess) { fprintf(stderr, "kernel_launch: hipFuncSetAttribute failed\n"); grid = -1; return; }
        if (hipOccupancyMaxActiveBlocksPerMultiprocessor(&per_cu, (const void*)fwd_kernel, 512, LDS_BYTES) != hipSuccess || per_cu < 1) { fprintf(stderr, "kernel_launch: occupancy query says %d\n", per_cu); }
        (void)hipGetLastError();
        grid = cus;
    }
    if (grid < 0) return;
    if (hipMemsetAsync((char*)d_ws + WS_CTL, 0, CTL_ZERO_BYTES, stream) != hipSuccess) return;
    Args a{};
    for (int i = 0; i < 24; ++i) a.in[i] = (const float*)d_in[i];
    a.out = (float*)d_out; a.ws = (unsigned char*)d_ws;
#if MK_PER_PHASE_LAUNCH
    for (int p = 0; p < NPHASES; ++p) {
        a.ph_lo = p; a.ph_hi = p + 1;
        hipLaunchKernelGGL(fwd_kernel, dim3(grid), dim3(512), LDS_BYTES, stream, a);
    }
#elif MK_PROBE >= 0
    {
        int cur = 0, slot = 0;
        for (int l = 0; l < DEPTH; ++l) { const int p = 2 + l * NPH_L + MK_PROBE;
            a.ph_lo = cur; a.ph_hi = p + 1; a.bar_slot = slot++; hipLaunchKernelGGL(fwd_kernel, dim3(grid), dim3(512), LDS_BYTES, stream, a);
            for (int r = 0; r < MK_PROBE_REP; ++r) { a.ph_lo = p; a.ph_hi = (p + 1) | (MK_PROBE_DRY << 16); a.bar_slot = slot++; hipLaunchKernelGGL(fwd_kernel, dim3(grid), dim3(512), LDS_BYTES, stream, a); }
            cur = p + 1; }
        a.ph_lo = cur; a.ph_hi = NPHASES; a.bar_slot = slot++; hipLaunchKernelGGL(fwd_kernel, dim3(grid), dim3(512), LDS_BYTES, stream, a);
    }
#else
    a.ph_lo = 0; a.ph_hi = NPHASES; a.bar_slot = 0;
    hipLaunchKernelGGL(fwd_kernel, dim3(grid), dim3(512), LDS_BYTES, stream, a);
#endif
}
```
